# Optimizing an MI355X kernel written in HIP

```python
import jax, jax.numpy as jnp
from jax import lax
import numpy as np

D_MODEL = 1024
BATCH = 8
SEQ = 8192
DEPTH = 1

SBA_HEADS = 8
SBA_HEAD_DIM = 64
SBA_WIDTH = SBA_HEADS * SBA_HEAD_DIM
Q_BLOCK = 128
SGU_GROUPS = 8
SGU_GROUP_DIM = 64
SGU_WIDTH = SGU_GROUPS * SGU_GROUP_DIM
CHUNK = 128
N_BRANCHES = 2
IN_COLS = 3 * SBA_WIDTH + 2 * SGU_WIDTH + N_BRANCHES * D_MODEL
N_GROUPS = 4
EXPERTS_PER_GROUP = 8
N_EXPERTS = N_GROUPS * EXPERTS_PER_GROUP
TOP_K = 2
D_EXPERT = D_MODEL // 2
EXPERT_BLOCK = 128
N_MOD = 6
EPS = 1e-6

kernel_name = "hybrid_stickbreak_sgu_hmoe_block"


def rms_norm(x, g):
    xf = x.astype(jnp.float32)
    y = xf * lax.rsqrt(jnp.mean(xf * xf, axis=-1, keepdims=True) + EPS)
    return y.astype(x.dtype) * g


def modulate(xn, shift, scale):
    return xn * (1 + scale[:, None, :]) + shift[:, None, :]


def stick_breaking_attention(q, k, v):
    B, H, S, dh = q.shape
    nb = S // Q_BLOCK
    qb = q.reshape(B, H, nb, Q_BLOCK, dh).transpose(2, 0, 1, 3, 4)
    kf = k.astype(jnp.float32)
    kpos = jnp.arange(S)
    scale = dh ** -0.5

    def block(args):
        qi, i = args
        qpos = i * Q_BLOCK + jnp.arange(Q_BLOCK)
        causal = kpos[None, :] < qpos[:, None]
        z = jnp.einsum('bhqd,bhkd->bhqk', qi.astype(jnp.float32), kf) * scale
        log_stay = jnp.where(causal, jax.nn.log_sigmoid(-z), 0.0)
        after = lax.cumsum(log_stay, axis=3, reverse=True) - log_stay
        w = jnp.where(causal, jnp.exp(jax.nn.log_sigmoid(z) + after), 0.0)
        return jnp.einsum('bhqk,bhkd->bhqd', w.astype(v.dtype), v)

    out = lax.map(block, (qb, jnp.arange(nb)))
    return out.transpose(1, 2, 0, 3, 4).reshape(B, H, S, dh)


def spatial_gating(uv, g_v, w_s, b_s):
    B, S, _ = uv.shape
    u, v = jnp.split(jax.nn.gelu(uv), 2, axis=-1)
    vf = v.astype(jnp.float32)
    mu = jnp.mean(vf, axis=-1, keepdims=True)
    var = jnp.mean(jnp.square(vf - mu), axis=-1, keepdims=True)
    vn = ((vf - mu) * lax.rsqrt(var + EPS)).astype(v.dtype) * g_v
    w_causal = w_s * jnp.tril(jnp.ones((CHUNK, CHUNK), w_s.dtype))
    vc = vn.reshape(B, S // CHUNK, CHUNK, SGU_GROUPS, SGU_GROUP_DIM)
    mix = jnp.einsum('gts,bnsgc->bntgc', w_causal, vc) + b_s.T[None, None, :, :, None]
    return u * mix.reshape(B, S, SGU_WIDTH)


def hierarchical_moe(xn, w_rg, b_rg, w_re, b_re, w_gate, w_up, w_down):
    B, S, D = xn.shape
    N = B * S
    xt = xn.reshape(N, D)
    g_logits = (xt @ w_rg + b_rg).astype(jnp.float32)
    g_prob = jax.nn.softmax(g_logits, axis=-1)
    g_sel = jnp.argmax(g_logits, axis=-1)
    g_w = jnp.take_along_axis(g_prob, g_sel[:, None], axis=-1)[:, 0]
    e_logits = (xt @ w_re + b_re).astype(jnp.float32).reshape(N, N_GROUPS, EXPERTS_PER_GROUP)
    e_logits = jnp.take_along_axis(e_logits, g_sel[:, None, None], axis=1)[:, 0]
    top_l, top_j = lax.top_k(e_logits, TOP_K)
    top_w = jax.nn.softmax(top_l, axis=-1) * g_w[:, None]
    eid = (g_sel[:, None] * EXPERTS_PER_GROUP + top_j).reshape(-1)
    tok = jnp.repeat(jnp.arange(N), TOP_K)
    wts = top_w.reshape(-1)
    M = eid.shape[0]

    order = jnp.argsort(eid)
    e_s, tok_s, w_s = eid[order], tok[order], wts[order]
    counts = jnp.bincount(eid, length=N_EXPERTS)
    padded = (counts + EXPERT_BLOCK - 1) // EXPERT_BLOCK * EXPERT_BLOCK
    start = jnp.cumsum(counts) - counts
    pend = jnp.cumsum(padded)
    pstart = pend - padded
    dest = pstart[e_s] + jnp.arange(M) - start[e_s]
    m_pad = M + N_EXPERTS * EXPERT_BLOCK
    nblk = m_pad // EXPERT_BLOCK
    tok_buf = jnp.full((m_pad,), N, jnp.int32).at[dest].set(tok_s.astype(jnp.int32))
    w_buf = jnp.zeros((m_pad,), jnp.float32).at[dest].set(w_s)
    blk_e = jnp.minimum(jnp.searchsorted(pend, jnp.arange(nblk) * EXPERT_BLOCK, side='right'),
                        N_EXPERTS - 1)
    x_pad = jnp.concatenate([xt, jnp.zeros((1, D), xt.dtype)], axis=0)
    xb = x_pad[tok_buf].reshape(nblk, EXPERT_BLOCK, D)

    def expert_block(args):
        xblk, e = args
        hid = jax.nn.silu(xblk @ w_gate[e]) * (xblk @ w_up[e])
        return hid @ w_down[e]

    yb = lax.map(expert_block, (xb, blk_e)).reshape(m_pad, D)
    y = jax.ops.segment_sum(yb.astype(jnp.float32) * w_buf[:, None], tok_buf, num_segments=N + 1)[:N]
    return y.astype(xn.dtype).reshape(B, S, D)


def setup_inputs(seed: int = 0) -> dict:
    key = jax.random.key(seed)
    ks = jax.random.split(key, 24)
    f32 = jnp.float32
    L, D = DEPTH, D_MODEL
    nrm = lambda k, shp, s: jax.random.normal(k, shp, f32) * s
    return {
        "x": nrm(ks[0], (BATCH, SEQ, D), 1.0),
        "c": nrm(ks[1], (BATCH, D), 1.0),
        "g_mix": 1.0 + nrm(ks[2], (L, D), 0.02),
        "g_ffn": 1.0 + nrm(ks[3], (L, D), 0.02),
        "w_ada": nrm(ks[4], (L, D, N_MOD * D), 0.5 * D ** -0.5),
        "b_ada": nrm(ks[5], (L, N_MOD * D), 0.02),
        "w_in": nrm(ks[6], (L, D, IN_COLS), D ** -0.5),
        "w_sba_out": nrm(ks[7], (L, SBA_WIDTH, D), SBA_WIDTH ** -0.5),
        "g_sgu": 1.0 + nrm(ks[8], (L, SGU_WIDTH), 0.02),
        "w_spatial": nrm(ks[9], (L, SGU_GROUPS, CHUNK, CHUNK), CHUNK ** -0.5),
        "b_spatial": 1.0 + nrm(ks[10], (L, SGU_GROUPS, CHUNK), 0.02),
        "w_sgu_out": nrm(ks[11], (L, SGU_WIDTH, D), SGU_WIDTH ** -0.5),
        "w_out": nrm(ks[12], (L, D, D), D ** -0.5),
        "w_router_group": nrm(ks[13], (L, D, N_GROUPS), D ** -0.5),
        "b_router_group": nrm(ks[14], (L, N_GROUPS), 0.01),
        "w_router_expert": nrm(ks[15], (L, D, N_EXPERTS), D ** -0.5),
        "b_router_expert": nrm(ks[16], (L, N_EXPERTS), 0.01),
        "w_expert_gate": nrm(ks[17], (L, N_EXPERTS, D, D_EXPERT), D ** -0.5),
        "w_expert_up": nrm(ks[18], (L, N_EXPERTS, D, D_EXPERT), D ** -0.5),
        "w_expert_down": nrm(ks[19], (L, N_EXPERTS, D_EXPERT, D), D_EXPERT ** -0.5),
        "g_final": 1.0 + nrm(ks[20], (D,), 0.02),
    }


def reference(x, c, g_mix, g_ffn, w_ada, b_ada, w_in, w_sba_out, g_sgu, w_spatial, b_spatial,
              w_sgu_out, w_out, w_router_group, b_router_group, w_router_expert, b_router_expert,
              w_expert_gate, w_expert_up, w_expert_down, g_final):
    B, S, D = x.shape
    h = x
    c_act = jax.nn.silu(c)
    splits = [SBA_WIDTH, 2 * SBA_WIDTH, 3 * SBA_WIDTH, 3 * SBA_WIDTH + 2 * SGU_WIDTH]

    def heads(t):
        return t.reshape(B, S, SBA_HEADS, SBA_HEAD_DIM).transpose(0, 2, 1, 3)

    for l in range(DEPTH):
        mod = c_act @ w_ada[l] + b_ada[l]
        sh_m, sc_m, gt_m, sh_f, sc_f, gt_f = jnp.split(mod, N_MOD, axis=-1)

        n = modulate(rms_norm(h, g_mix[l]), sh_m, sc_m)
        proj = n @ w_in[l]
        q, k, v, uv, gates = jnp.split(proj, splits, axis=-1)
        y_a = stick_breaking_attention(heads(q), heads(k), heads(v))
        y_a = y_a.transpose(0, 2, 1, 3).reshape(B, S, SBA_WIDTH)
        y_b = spatial_gating(uv, g_sgu[l], w_spatial[l], b_spatial[l])
        gate_a, gate_b = jnp.split(jax.nn.sigmoid(gates), N_BRANCHES, axis=-1)
        merged = gate_a * (y_a @ w_sba_out[l]) + gate_b * (y_b @ w_sgu_out[l])
        h = h + gt_m[:, None, :] * (merged @ w_out[l])

        n = modulate(rms_norm(h, g_ffn[l]), sh_f, sc_f)
        y = hierarchical_moe(n, w_router_group[l], b_router_group[l], w_router_expert[l],
                             b_router_expert[l], w_expert_gate[l], w_expert_up[l], w_expert_down[l])
        h = h + gt_f[:, None, :] * y
    return rms_norm(h, g_final)
```

```cpp
#include <hip/hip_runtime.h>
#include <cstdio>
#include <cstdint>

#ifndef MK_N_LAUNCHES
#define MK_N_LAUNCHES 1
#endif

#define GAS __attribute__((address_space(1)))
#define LAS __attribute__((address_space(3)))
typedef unsigned short bf16_t;
typedef short bf16x8 __attribute__((ext_vector_type(8)));
typedef short s16x4 __attribute__((ext_vector_type(4)));
typedef float f32x2 __attribute__((ext_vector_type(2)));
typedef float f32x4 __attribute__((ext_vector_type(4)));
typedef float f32x16 __attribute__((ext_vector_type(16)));
typedef unsigned u32x2 __attribute__((ext_vector_type(2)));
typedef unsigned u32x4 __attribute__((ext_vector_type(4)));
typedef __bf16 bf16x2_t __attribute__((ext_vector_type(2)));
typedef GAS unsigned gu32;

constexpr int NB = 8, SEQ = 8192, DM = 1024, NTOK = NB * SEQ;
constexpr int LDP = 4608;
constexpr int C_Q = 0, C_K = 512, C_V = 1024, C_U = 1536, C_SV = 2048, C_GA = 2560, C_GB = 3584;
constexpr size_t PO_Q = 0, PO_K = (size_t)32 << 20, PO_V = (size_t)64 << 20, PO_U = (size_t)96 << 20, PO_SV = (size_t)128 << 20, PO_GA = (size_t)160 << 20, PO_GB = (size_t)224 << 20;
constexpr int NEXP = 32, DEXP = 512;
constexpr float EPS = 1e-6f;
constexpr float LOG2E = 1.4426950408889634f;
constexpr float QS_N = 127.0f / 8.0f;
constexpr float QS_WIN = 127.0f * 32.0f / 4.5f;
constexpr float DQ_PROJ = 1.0f / (QS_N * QS_WIN);
constexpr float QS_MERGED = 127.0f / 4.0f;
constexpr float QS_WOUT = 127.0f * 32.0f / 4.5f;

constexpr size_t MiB = 1u << 20;
constexpr size_t WS_CTL = 0, CTL_ZERO_BYTES = 1 * MiB;
constexpr size_t WS_MOD = 1 * MiB;
constexpr size_t WS_WSP = 2 * MiB;
constexpr size_t WS_WR = 2 * MiB + 512 * 1024;
constexpr size_t WS_STATS = 3 * MiB;
constexpr size_t WS_LIST = 8 * MiB;
constexpr size_t WS_WIN = 24 * MiB;
constexpr size_t WS_WA = 33 * MiB, WS_WB = 34 * MiB;
constexpr size_t WS_WO = 35 * MiB;
constexpr size_t WS_BT1 = 40 * MiB;
constexpr size_t WS_BT2 = 104 * MiB;
constexpr size_t WS_WIN8 = 120 * MiB;
constexpr size_t WS_XN = 136 * MiB;
constexpr size_t WS_YA = 264 * MiB, WS_YB = 328 * MiB;
constexpr size_t WS_P = 392 * MiB;
constexpr size_t WS_HID = WS_P;
constexpr size_t WS_YBUF = WS_P + 136 * MiB;
constexpr size_t WS_END = WS_P + 576 * MiB;

constexpr int CW_TMO = 0, CW_CODE = 1;
constexpr int CW_BAR = 4096;
constexpr int CW_CNT = 65536;

constexpr int LDS_BYTES = 163840;
constexpr int RING_BYTES = 131072;
constexpr int GTAB_OFF = 131072;
constexpr int UTAB_OFF = GTAB_OFF + 9 * 1024;
constexpr int MOEB_OFF = UTAB_OFF + 128;
constexpr int ETAB_OFF = MOEB_OFF + 512;
constexpr int MISC_OFF = LDS_BYTES - 256;
constexpr int NWAVES = 8;

__device__ __forceinline__ unsigned cvtpk(float lo, float hi) { f32x2 v = {lo, hi}; bf16x2_t b = __builtin_convertvector(v, bf16x2_t); return __builtin_bit_cast(unsigned, b); }
__device__ __forceinline__ float bf_lo(unsigned u) { return __uint_as_float(u << 16); }
__device__ __forceinline__ float bf_hi(unsigned u) { return __uint_as_float(u & 0xffff0000u); }
__device__ __forceinline__ float wave_sum(float v) {
#pragma unroll
    for (int o = 1; o < 64; o <<= 1) v += __shfl_xor(v, o);
    return v;
}
__device__ __forceinline__ float fast_exp2(float x) { return __builtin_amdgcn_exp2f(x); }
__device__ __forceinline__ float fast_log2(float x) { return __builtin_amdgcn_logf(x); }
__device__ __forceinline__ float fast_rcp(float x) { return __builtin_amdgcn_rcpf(x); }
__device__ __forceinline__ float sigmoidf_(float x) { return fast_rcp(1.0f + fast_exp2(-x * LOG2E)); }
__device__ __forceinline__ float siluf_(float x) { return x * sigmoidf_(x); }
__device__ __forceinline__ float gelu_tanh_(float x) {
    const float u = x * (1.0f + 0.044715f * x * x);
    return x * fast_rcp(1.0f + fast_exp2(-2.0f * 0.7978845608028654f * LOG2E * u));
}
__device__ __forceinline__ unsigned pk4_fp8(float a, float b, float c, float d) {
    int p = __builtin_amdgcn_cvt_pk_fp8_f32(a, b, 0, false); p = __builtin_amdgcn_cvt_pk_fp8_f32(c, d, p, true); return (unsigned)p; }
__device__ __forceinline__ unsigned pk4_i8(float a, float b, float c, float d) {
    const int ia = (int)__builtin_rintf(__builtin_amdgcn_fmed3f(a, -127.0f, 127.0f)), ib = (int)__builtin_rintf(__builtin_amdgcn_fmed3f(b, -127.0f, 127.0f));
    const int ic = (int)__builtin_rintf(__builtin_amdgcn_fmed3f(c, -127.0f, 127.0f)), id = (int)__builtin_rintf(__builtin_amdgcn_fmed3f(d, -127.0f, 127.0f));
    return (unsigned)(ia & 255) | ((unsigned)(ib & 255) << 8) | ((unsigned)(ic & 255) << 16) | ((unsigned)(id & 255) << 24); }
#define LDS_WAIT() asm volatile("s_waitcnt lgkmcnt(0)" ::: "memory")
#define VM_WAIT() asm volatile("s_waitcnt vmcnt(0)" ::: "memory")

namespace pg8 {
constexpr int BM = 256, BK = 64, HALF = 128, HTB = HALF * BK * 2, STAGE_BYTES = 8 * HTB, NXCD = 8, WGM = 8;
__host__ __device__ __forceinline__ int lds_byte(int r, int c) { const int st = (r >> 4) * 2 + (c >> 5), rr = r & 15, cc = c & 31, ob = rr * 64 + cc * 2; return st * 1024 + (ob ^ (((ob >> 9) & 1) << 5)); }
__host__ __device__ __forceinline__ void stage_rc(int b, int& R, int& C) { const int st = b / 1024, sb = b % 1024, swz = sb ^ (((sb >> 9) & 1) << 5); R = (st >> 1) * 16 + swz / 64; C = (st & 1) * 32 + (swz % 64) / 2; }
__host__ __device__ __forceinline__ int perm32(int rho) { const int n = rho >> 4, i = rho & 15; return 8 * (i >> 2) + 4 * n + (i & 3); }

struct Unit { int pm, pn; };
struct Gemm { const bf16_t* A; const bf16_t* Bt; int lda, ldb, K; };

struct StaticOrder {
    int nM, nN, nwg, G, c;
    __host__ __device__ void init(int M, int N, int G_, int c_) { nM = M / BM; nN = N / BM; nwg = nM * nN; G = G_; c = c_; }
    __host__ __device__ bool next(int i, Unit& u) const {
        const long L = (long)i * G + c; if (L >= nwg) return false;
        int wgid = (int)L; { const int q = nwg / NXCD, r = nwg % NXCD, xcd = wgid % NXCD, off = wgid / NXCD; wgid = (xcd < r ? xcd * (q + 1) : r * (q + 1) + (xcd - r) * q) + off; }
        const int nig = WGM * nN, gid = wgid / nig, fm = gid * WGM, gsz = (nM - fm) < WGM ? (nM - fm) : WGM;
        u.pm = fm + ((wgid % nig) % gsz); u.pn = (wgid % nig) / gsz; return true;
    }
};
struct TableOrder {
    const LAS int* tab; int n;
    __device__ __forceinline__ bool next(int i, Unit& u) const { if (i >= n) return false; u.pm = tab[2 * i]; u.pn = tab[2 * i + 1]; return true; }
};

typedef int i32x4_t __attribute__((ext_vector_type(4)));
typedef int i32x8_t __attribute__((ext_vector_type(8)));
__device__ __forceinline__ i32x8_t cat8(bf16x8 lo, bf16x8 hi) { const i32x4_t a = __builtin_bit_cast(i32x4_t, lo), b = __builtin_bit_cast(i32x4_t, hi); return __builtin_shufflevector(a, b, 0, 1, 2, 3, 4, 5, 6, 7); }
template <class Epi, class Sched, bool ALIGN_EPI, bool GATHER, bool MIDK = false, bool FP8 = false, bool I8 = false>
__device__ __forceinline__ void gemm_phase(LAS unsigned char* lds, const Gemm g, const Sched& S, const Epi& E, const LAS unsigned* gtab) {
    const int tid = threadIdx.x, wid = __builtin_amdgcn_readfirstlane(tid >> 6), lane = tid & 63, wr = wid >> 2, wc = wid & 3, fr = lane & 15, fq = lane >> 4;
    constexpr int ESZ = (FP8 || I8) ? 1 : 2;
    const int K = g.K, nt = K * ESZ / (BK * 2);
    unsigned voffA[2], voffB[2];
    unsigned vG[2][2];
#pragma unroll
    for (int i = 0; i < 2; ++i) { int R, C; stage_rc(tid * 16 + i * 8192, R, C); const int Rb = Epi::PERM ? ((R & ~31) + perm32(R & 31)) : R;
        voffA[i] = (unsigned)(R * g.lda * ESZ + C * 2); voffB[i] = (unsigned)(Rb * g.ldb * ESZ + C * 2); vG[0][i] = 0u; vG[1][i] = 0u; }
    const size_t kstep = (size_t)(BK * 2);
    const size_t hstepA = (size_t)HALF * g.lda * ESZ, hstepB = (size_t)HALF * g.ldb * ESZ;
    const size_t tstepA = 2 * hstepA, tstepB = 2 * hstepB;
    const unsigned ldsw = (unsigned)wid * 1024u;
    constexpr int DK = FP8 ? 16 : 1024;
    const int aoff = lds_byte(wr * 64 + fr, FP8 ? 16 * fq : fq * 8), boff = lds_byte(wc * 32 + fr, FP8 ? 16 * fq : fq * 8);
#define PG8_SA(b, h) (((b) * 2 + (h)) * HTB)
#define PG8_SB(b, h) ((4 + (b) * 2 + (h)) * HTB)
#define PG8_STAGE(bufoff, gbase, voff) do { _Pragma("unroll") for (int _i = 0; _i < 2; ++_i) \
        __builtin_amdgcn_global_load_lds((const unsigned*)((const char*)(gbase) + (voff)[_i]), (LAS unsigned*)(lds + (bufoff) + ldsw + _i * 8192), 16, 0, 0); } while (0)
#define PG8_STAGE_A(b, h, ptr) do { if constexpr (GATHER) { PG8_STAGE(PG8_SA(b, h), (ptr), vG[h]); } else { PG8_STAGE(PG8_SA(b, h), (ptr) + (h) * hstepA, voffA); } } while (0)
#define PG8_LOADG(ui_) do { _Pragma("unroll") for (int _i = 0; _i < 2; ++_i) { int R_, C_; stage_rc(tid * 16 + _i * 8192, R_, C_); \
        vG[0][_i] = gtab[(ui_) * 256 + R_] + (unsigned)(C_ * 2); vG[1][_i] = gtab[(ui_) * 256 + 128 + R_] + (unsigned)(C_ * 2); } } while (0)
#define PG8_LDA(dst, b, h) do { _Pragma("unroll") for (int m = 0; m < 4; ++m) _Pragma("unroll") for (int k = 0; k < 2; ++k) dst[m][k] = *(const LAS bf16x8*)(lds + PG8_SA(b, h) + aoff + m * 2048 + k * DK); } while (0)
#define PG8_LDB(dst, b, h) do { _Pragma("unroll") for (int n = 0; n < 2; ++n) _Pragma("unroll") for (int k = 0; k < 2; ++k) dst[n][k] = *(const LAS bf16x8*)(lds + PG8_SB(b, h) + boff + n * 2048 + k * DK); } while (0)
#define PG8_MMA(ai, bj, At, Bt) do { __builtin_amdgcn_s_setprio(1); _Pragma("unroll") for (int m = 0; m < 4; ++m) _Pragma("unroll") for (int n = 0; n < 2; ++n) { \
        if constexpr (FP8) { acc[ai][bj][m][n] = __builtin_amdgcn_mfma_scale_f32_16x16x128_f8f6f4(cat8(Bt[n][0], Bt[n][1]), cat8(At[m][0], At[m][1]), acc[ai][bj][m][n], 0, 0, 0, 0x7f7f7f7f, 0, 0x7f7f7f7f); } \
        else if constexpr (I8) { _Pragma("unroll") for (int k = 0; k < 2; ++k) acc[ai][bj][m][n] = __builtin_bit_cast(f32x4, __builtin_amdgcn_mfma_i32_16x16x64_i8(__builtin_bit_cast(i32x4_t, Bt[n][k]), __builtin_bit_cast(i32x4_t, At[m][k]), __builtin_bit_cast(i32x4_t, acc[ai][bj][m][n]), 0, 0, 0)); } \
        else { _Pragma("unroll") for (int k = 0; k < 2; ++k) acc[ai][bj][m][n] = __builtin_amdgcn_mfma_f32_16x16x32_bf16(Bt[n][k], At[m][k], acc[ai][bj][m][n], 0, 0, 0); } } \
        __builtin_amdgcn_s_setprio(0); } while (0)
#define PG8_WAIT_V(n) asm volatile("s_waitcnt vmcnt(" #n ")" ::: "memory")
#define PG8_WAIT_L(n) asm volatile("s_waitcnt lgkmcnt(" #n ")" ::: "memory")
#define PG8_BAR __builtin_amdgcn_s_barrier()
#define PG8_SCHED __builtin_amdgcn_sched_barrier(0)
    Unit cur, nxt; int ui = 0;
    if (!S.next(0, cur)) return;
    f32x4 acc[2][2][4][2];
#pragma unroll
    for (int a = 0; a < 2; ++a)
#pragma unroll
        for (int b = 0; b < 2; ++b)
#pragma unroll
            for (int m = 0; m < 4; ++m)
#pragma unroll
                for (int n = 0; n < 2; ++n) acc[a][b][m][n] = (f32x4){0.f, 0.f, 0.f, 0.f};
    bf16x8 At[4][2], B0[2][2], B1[2][2];
    const char* cA = (const char*)g.A + (GATHER ? (size_t)0 : (size_t)cur.pm * tstepA); const char* cB = (const char*)g.Bt + (size_t)cur.pn * tstepB;
    if constexpr (GATHER) { PG8_LOADG(0); }
    PG8_STAGE(PG8_SB(0, 0), cB, voffB); PG8_STAGE(PG8_SB(0, 1), cB + hstepB, voffB); PG8_STAGE_A(0, 0, cA); PG8_STAGE_A(0, 1, cA);
    if (wr == 1) PG8_BAR;
    PG8_WAIT_V(2); PG8_BAR;
    PG8_STAGE(PG8_SB(1, 0), cB + kstep, voffB); PG8_STAGE_A(1, 0, cA + kstep); PG8_STAGE(PG8_SB(1, 1), cB + hstepB + kstep, voffB);
    PG8_WAIT_V(6); PG8_BAR;
    for (;;) {
        const bool has_next = S.next(ui + 1, nxt);
        const char* nA = has_next ? (const char*)g.A + (GATHER ? (size_t)0 : (size_t)nxt.pm * tstepA) : cA; const char* nB = has_next ? (const char*)g.Bt + (size_t)nxt.pn * tstepB : cB;
#pragma nounroll
        for (int t = 0; t < nt; t += 2) {
            const bool last = (t == nt - 2);
            const char* a1 = cA + (size_t)(t + 1) * kstep;
            const char* a2 = last ? nA : cA + (size_t)(t + 2) * kstep; const char* b2 = last ? nB : cB + (size_t)(t + 2) * kstep;
            const char* a3 = a2 + kstep; const char* b3 = b2 + kstep;
            if constexpr (MIDK) { if (t == (nt >> 1)) E.mid(acc, cur, wr, wc, fr, fq); }
            PG8_LDB(B0, 0, 0); PG8_LDB(B1, 0, 1); PG8_SCHED; PG8_LDA(At, 0, 0); PG8_STAGE_A(1, 1, a1);
            if constexpr (GATHER) { if (last && has_next) { PG8_LOADG(ui + 1); } }
            PG8_WAIT_V(8); PG8_WAIT_L(0); PG8_BAR; PG8_MMA(0, 0, At, B0); PG8_MMA(0, 1, At, B1); PG8_BAR; PG8_SCHED;
            PG8_LDA(At, 0, 1); PG8_STAGE(PG8_SB(0, 0), b2, voffB); PG8_STAGE(PG8_SB(0, 1), b2 + hstepB, voffB); PG8_STAGE_A(0, 0, a2);
            PG8_WAIT_V(8); PG8_WAIT_L(0); PG8_BAR; PG8_MMA(1, 0, At, B0); PG8_MMA(1, 1, At, B1); PG8_BAR; PG8_SCHED;
            PG8_LDB(B0, 1, 0); PG8_LDB(B1, 1, 1); PG8_SCHED; PG8_LDA(At, 1, 0); PG8_STAGE_A(0, 1, a2);
            PG8_WAIT_V(8); PG8_WAIT_L(0); PG8_BAR; PG8_MMA(0, 0, At, B0); PG8_MMA(0, 1, At, B1); PG8_BAR; PG8_SCHED;
            PG8_LDA(At, 1, 1); PG8_STAGE(PG8_SB(1, 0), b3, voffB); PG8_STAGE(PG8_SB(1, 1), b3 + hstepB, voffB); PG8_STAGE_A(1, 0, a3);
            PG8_WAIT_V(8); PG8_WAIT_L(0); PG8_BAR; PG8_MMA(1, 0, At, B0); PG8_MMA(1, 1, At, B1); PG8_BAR; PG8_SCHED;
        }
        if constexpr (ALIGN_EPI) { if (wr == 0) PG8_BAR; }
        E(acc, cur, ui, wr, wc, fr, fq);
        if (!has_next) break;
#pragma unroll
        for (int a = 0; a < 2; ++a)
#pragma unroll
            for (int b = 0; b < 2; ++b)
#pragma unroll
                for (int m = 0; m < 4; ++m)
#pragma unroll
                    for (int n = 0; n < 2; ++n) acc[a][b][m][n] = (f32x4){0.f, 0.f, 0.f, 0.f};
        cur = nxt; cA = nA; cB = nB; ++ui;
        if constexpr (ALIGN_EPI) { if (wr == 1) PG8_BAR; }
    }
    PG8_WAIT_V(0);
    if constexpr (!ALIGN_EPI) { if (wr == 0) PG8_BAR; }
    PG8_BAR;
#undef PG8_SA
#undef PG8_SB
#undef PG8_STAGE
#undef PG8_STAGE_A
#undef PG8_LOADG
#undef PG8_LDA
#undef PG8_LDB
#undef PG8_MMA
#undef PG8_WAIT_V
#undef PG8_WAIT_L
#undef PG8_BAR
#undef PG8_SCHED
}

typedef f32x4 AccT[2][2][4][2];

struct EpiProj {
    static constexpr bool PERM = true;
    bf16_t* O; f32x2* svst;
    template <int MODE, bool STATS, int LAYOUT> __device__ __forceinline__ void run(const AccT& acc, const Unit& u, int wr, int wc, int fr, int fq) const {
        const int row0 = u.pm * BM + wr * 64 + fr, colt = wc * 32 + 8 * fq;
        const int pn = u.pn; bf16_t* base; size_t pitch = 0; int c0 = 0; size_t bjstep = HALF;
        if (pn < 6) { const int b = (u.pm * BM) / SEQ, hd = 4 * (pn & 1) + (colt >> 6);
            base = O + (size_t)(pn >> 1) * PO_K + ((size_t)(b * 8 + hd) * SEQ - (size_t)b * SEQ) * 64; pitch = 64; c0 = colt & 63; bjstep = (size_t)2 * SEQ * 64; }
        else if (pn < 8) { base = O + PO_U; c0 = (pn & 1) * 32 + (colt >> 3); bjstep = 16 * 256; }
        else if (pn < 10) { base = O + PO_SV; pitch = 512; c0 = (pn & 1) * 256 + colt; }
        else { base = O + (pn < 14 ? PO_GA : PO_GB); pitch = 1024; c0 = ((pn - 10) & 3) * 256 + colt; }
#pragma unroll
        for (int ai = 0; ai < 2; ++ai)
#pragma unroll
            for (int m = 0; m < 4; ++m) { const int row = row0 + ai * HALF + m * 16; float s1 = 0.f, s2 = 0.f;
                bf16_t* rowp;
                if (LAYOUT == 0) rowp = base + (size_t)row * pitch + c0;
                else if (LAYOUT == 1) rowp = base + (size_t)(row & ~31) * 64 + (c0 >> 3) * 256 + (row & 31) * 8;
                else rowp = base + ((size_t)(row >> 5) * 64 + c0) * 256 + (row & 31) * 8;
#pragma unroll
                for (int bj = 0; bj < 2; ++bj) { float v[8];
#pragma unroll
                    for (int j = 0; j < 4; ++j) { v[j] = (float)__builtin_bit_cast(i32x4_t, acc[ai][bj][m][0])[j] * DQ_PROJ; v[4 + j] = (float)__builtin_bit_cast(i32x4_t, acc[ai][bj][m][1])[j] * DQ_PROJ; }
#pragma unroll
                    for (int j = 0; j < 8; ++j) {
                        if (MODE == 1) v[j] = v[j] * (0.125f * LOG2E);
                        if (MODE == 2) v[j] = gelu_tanh_(v[j]);
                        if (MODE == 3) v[j] = sigmoidf_(v[j]);
                        if (STATS) { s1 += v[j]; s2 += v[j] * v[j]; } }
                    u32x4 w; w.x = cvtpk(v[0], v[1]); w.y = cvtpk(v[2], v[3]); w.z = cvtpk(v[4], v[5]); w.w = cvtpk(v[6], v[7]);
                    *(u32x4*)(rowp + bj * bjstep) = w; }
                if (STATS) { s1 += __shfl_xor(s1, 16); s1 += __shfl_xor(s1, 32); s2 += __shfl_xor(s2, 16); s2 += __shfl_xor(s2, 32);
                    if (fq == 0) svst[(size_t)row * 8 + (u.pn - 8) * 4 + wc] = (f32x2){s1, s2}; } }
    }
    __device__ __forceinline__ void run_gates(const AccT& acc, const Unit& u, int wr, int wc, int fr, int fq) const {
        const int row0 = u.pm * BM + wr * 64 + fr, col0 = (u.pn - 10) * HALF + wc * 32 + 8 * fq;
#pragma unroll
        for (int ai = 0; ai < 2; ++ai)
#pragma unroll
            for (int m = 0; m < 4; ++m) { float rv[8], sv[8];
#pragma unroll
                for (int j = 0; j < 8; ++j) { const float a = (float)__builtin_bit_cast(i32x4_t, acc[ai][0][m][j >> 2])[j & 3], b = (float)__builtin_bit_cast(i32x4_t, acc[ai][1][m][j >> 2])[j & 3];
                    const float eb = fast_exp2(b * (-LOG2E * DQ_PROJ)), ea = fast_exp2(a * (-LOG2E * DQ_PROJ));
                    sv[j] = fast_rcp(1.0f + eb); rv[j] = (1.0f + eb) * fast_rcp(1.0f + ea); }
                u32x4 wr_; wr_.x = cvtpk(rv[0], rv[1]); wr_.y = cvtpk(rv[2], rv[3]); wr_.z = cvtpk(rv[4], rv[5]); wr_.w = cvtpk(rv[6], rv[7]);
                unsigned q8[8];
#pragma unroll
                for (int j = 0; j < 8; ++j) q8[j] = (unsigned)(sv[j] * 255.0f + 0.5f);
                u32x2 wb; wb.x = q8[0] | (q8[1] << 8) | (q8[2] << 16) | (q8[3] << 24); wb.y = q8[4] | (q8[5] << 8) | (q8[6] << 16) | (q8[7] << 24);
                const size_t off = (size_t)(row0 + ai * HALF + m * 16) * DM + col0;
                *(u32x4*)(O + PO_GA + off) = wr_; *(u32x2*)((unsigned char*)(O + PO_GB) + off) = wb; }
    }
    __device__ __forceinline__ void operator()(const AccT& acc, const Unit& u, int, int wr, int wc, int fr, int fq) const {
        const int pn = u.pn;
        if (pn < 2) run<1, false, 1>(acc, u, wr, wc, fr, fq); else if (pn < 4) run<0, false, 1>(acc, u, wr, wc, fr, fq); else if (pn < 6) run<0, false, 0>(acc, u, wr, wc, fr, fq);
        else if (pn < 8) run<2, false, 2>(acc, u, wr, wc, fr, fq); else if (pn < 10) run<2, true, 0>(acc, u, wr, wc, fr, fq); else run_gates(acc, u, wr, wc, fr, fq);
    }
};

struct EpiGates {
    static constexpr bool PERM = true;
    bf16_t* O;
    __device__ __forceinline__ void operator()(const AccT& acc, const Unit& u, int, int wr, int wc, int fr, int fq) const {
        const int row0 = u.pm * BM + wr * 64 + fr, col0 = u.pn * HALF + wc * 32 + 8 * fq;
#pragma unroll
        for (int ai = 0; ai < 2; ++ai)
#pragma unroll
            for (int m = 0; m < 4; ++m) { float rv[8], sv[8];
#pragma unroll
                for (int j = 0; j < 8; ++j) { const float a = acc[ai][0][m][j >> 2][j & 3], b = acc[ai][1][m][j >> 2][j & 3];
                    const float eb = fast_exp2(b * (-LOG2E / 32.0f)), ea = fast_exp2(a * (-LOG2E / 32.0f));
                    sv[j] = fast_rcp(1.0f + eb); rv[j] = (1.0f + eb) * fast_rcp(1.0f + ea); }
                u32x4 wr_; wr_.x = cvtpk(rv[0], rv[1]); wr_.y = cvtpk(rv[2], rv[3]); wr_.z = cvtpk(rv[4], rv[5]); wr_.w = cvtpk(rv[6], rv[7]);
                unsigned q8[8];
#pragma unroll
                for (int j = 0; j < 8; ++j) q8[j] = (unsigned)(sv[j] * 255.0f + 0.5f);
                u32x2 wb; wb.x = q8[0] | (q8[1] << 8) | (q8[2] << 16) | (q8[3] << 24); wb.y = q8[4] | (q8[5] << 8) | (q8[6] << 16) | (q8[7] << 24);
                const size_t off = (size_t)(row0 + ai * HALF + m * 16) * DM + col0;
                *(u32x4*)(O + PO_GA + off) = wr_; *(u32x2*)((unsigned char*)(O + PO_GB) + off) = wb; }
    }
};

struct EpiMerge {
    static constexpr bool PERM = true;
    unsigned char* O; const bf16_t* Pg;
    __device__ __forceinline__ void mid(AccT& acc, const Unit& u, int wr, int wc, int fr, int fq) const {
        int row0 = u.pm * BM + wr * 64 + fr, col0 = u.pn * BM + wc * 32 + 8 * fq;
        asm volatile("" : "+v"(row0), "+v"(col0));
        u32x4 rw[2][4][2];
#pragma unroll
        for (int ai = 0; ai < 2; ++ai)
#pragma unroll
            for (int m = 0; m < 4; ++m)
#pragma unroll
                for (int bj = 0; bj < 2; ++bj) rw[ai][m][bj] = *(const u32x4*)(Pg + PO_GA + (size_t)(row0 + ai * HALF + m * 16) * DM + col0 + bj * HALF);
#pragma unroll
        for (int ai = 0; ai < 2; ++ai)
#pragma unroll
            for (int m = 0; m < 4; ++m)
#pragma unroll
                for (int bj = 0; bj < 2; ++bj) { const u32x4 g = rw[ai][m][bj];
                    acc[ai][bj][m][0] *= (f32x4){bf_lo(g.x), bf_hi(g.x), bf_lo(g.y), bf_hi(g.y)}; acc[ai][bj][m][1] *= (f32x4){bf_lo(g.z), bf_hi(g.z), bf_lo(g.w), bf_hi(g.w)}; }
    }
    __device__ __forceinline__ void operator()(const AccT& acc, const Unit& u, int, int wr, int wc, int fr, int fq) const {
        const int row0 = u.pm * BM + wr * 64 + fr, col0 = u.pn * BM + wc * 32 + 8 * fq;
        u32x2 gw[2][4][2];
#pragma unroll
        for (int ai = 0; ai < 2; ++ai)
#pragma unroll
            for (int m = 0; m < 4; ++m)
#pragma unroll
                for (int bj = 0; bj < 2; ++bj) gw[ai][m][bj] = *(const u32x2*)((const unsigned char*)(Pg + PO_GB) + (size_t)(row0 + ai * HALF + m * 16) * DM + col0 + bj * HALF);
#pragma unroll
        for (int ai = 0; ai < 2; ++ai)
#pragma unroll
            for (int m = 0; m < 4; ++m) { const size_t row = (size_t)(row0 + ai * HALF + m * 16);
#pragma unroll
                for (int bj = 0; bj < 2; ++bj) { const u32x2 g4 = gw[ai][m][bj];
                    float v[8];
#pragma unroll
                    for (int j = 0; j < 4; ++j) { v[j] = acc[ai][bj][m][0][j] * ((float)((g4.x >> (8 * j)) & 255u) * (1.0f / 255.0f)); v[4 + j] = acc[ai][bj][m][1][j] * ((float)((g4.y >> (8 * j)) & 255u) * (1.0f / 255.0f)); }
                    u32x2 w; w.x = pk4_i8(QS_MERGED * v[0], QS_MERGED * v[1], QS_MERGED * v[2], QS_MERGED * v[3]); w.y = pk4_i8(QS_MERGED * v[4], QS_MERGED * v[5], QS_MERGED * v[6], QS_MERGED * v[7]);
                    *(u32x2*)(O + row * DM + col0 + bj * HALF) = w; } }
    }
};

struct EpiResid {
    static constexpr bool PERM = true;
    const float* X; bf16_t* H; const float* mod; float* stats;
    __device__ __forceinline__ void operator()(const AccT& acc, const Unit& u, int, int wr, int wc, int fr, int fq) const {
        const int rowt = u.pm * BM + wr * 64 + fr, col0 = u.pn * BM + wc * 32 + 8 * fq;
        const int b = (u.pm * BM) / SEQ;
        const float* gt = mod + (size_t)b * 6144 + 2 * DM;
        f32x4 g4[2][2];
#pragma unroll
        for (int bj = 0; bj < 2; ++bj)
#pragma unroll
            for (int n = 0; n < 2; ++n) g4[bj][n] = *(const f32x4*)(gt + col0 + bj * HALF + n * 4) * (1.0f / (QS_MERGED * QS_WOUT));
        f32x4 xv[4][2][2]; u32x4 wv[4][2]; float sq[4];
#pragma unroll
        for (int ai = 0; ai < 2; ++ai) {
#pragma unroll
            for (int m = 0; m < 4; ++m)
#pragma unroll
                for (int bj = 0; bj < 2; ++bj) { const size_t off = (size_t)(rowt + ai * HALF + m * 16) * DM + col0 + bj * HALF;
                    xv[m][bj][0] = *(const f32x4*)(X + off); xv[m][bj][1] = *(const f32x4*)(X + off + 4); }
            if (ai == 1) {
#pragma unroll
                for (int m = 0; m < 4; ++m) { const size_t row = (size_t)(rowt + m * 16);
#pragma unroll
                    for (int bj = 0; bj < 2; ++bj) *(u32x4*)(H + row * DM + col0 + bj * HALF) = wv[m][bj];
                    if (fq == 0) stats[row * 16 + u.pn * 4 + wc] = sq[m]; }
            }
#pragma unroll
            for (int m = 0; m < 4; ++m) { float ss = 0.f;
#pragma unroll
                for (int bj = 0; bj < 2; ++bj) {
                    const f32x4 h0 = xv[m][bj][0] + g4[bj][0] * __builtin_convertvector(__builtin_bit_cast(i32x4_t, acc[ai][bj][m][0]), f32x4), h1 = xv[m][bj][1] + g4[bj][1] * __builtin_convertvector(__builtin_bit_cast(i32x4_t, acc[ai][bj][m][1]), f32x4);
                    ss += (h0[0] * h0[0] + h0[1] * h0[1]) + (h0[2] * h0[2] + h0[3] * h0[3]) + (h1[0] * h1[0] + h1[1] * h1[1]) + (h1[2] * h1[2] + h1[3] * h1[3]);
                    wv[m][bj].x = cvtpk(h0[0], h0[1]); wv[m][bj].y = cvtpk(h0[2], h0[3]); wv[m][bj].z = cvtpk(h1[0], h1[1]); wv[m][bj].w = cvtpk(h1[2], h1[3]); }
                ss += __shfl_xor(ss, 16); ss += __shfl_xor(ss, 32); sq[m] = ss; }
            if (ai == 0) asm volatile("" : "+v"(wv[0][0]), "+v"(wv[0][1]), "+v"(wv[1][0]), "+v"(wv[1][1]), "+v"(wv[2][0]), "+v"(wv[2][1]), "+v"(wv[3][0]), "+v"(wv[3][1]));
        }
#pragma unroll
        for (int m = 0; m < 4; ++m) { const size_t row = (size_t)(rowt + HALF + m * 16);
#pragma unroll
            for (int bj = 0; bj < 2; ++bj) *(u32x4*)(H + row * DM + col0 + bj * HALF) = wv[m][bj];
            if (fq == 0) stats[row * 16 + u.pn * 4 + wc] = sq[m]; }
    }
};

struct EpiSwiglu {
    static constexpr bool PERM = true;
    unsigned char* Hid;
    __device__ __forceinline__ void operator()(const AccT& acc, const Unit& u, int, int wr, int wc, int fr, int fq) const {
        const int row0 = u.pm * BM + wr * 64 + fr, col0 = (u.pn & 3) * HALF + wc * 32 + 8 * fq;
#pragma unroll
        for (int ai = 0; ai < 2; ++ai)
#pragma unroll
            for (int m = 0; m < 4; ++m) { float v[8];
#pragma unroll
                for (int j = 0; j < 4; ++j) { v[j] = siluf_(acc[ai][0][m][0][j] * 0.03125f) * (acc[ai][1][m][0][j] * 0.03125f); v[4 + j] = siluf_(acc[ai][0][m][1][j] * 0.03125f) * (acc[ai][1][m][1][j] * 0.03125f); }
                u32x2 w; w.x = pk4_fp8(v[0], v[1], v[2], v[3]); w.y = pk4_fp8(v[4], v[5], v[6], v[7]);
                *(u32x2*)(Hid + (size_t)(row0 + ai * HALF + m * 16) * DEXP + col0) = w; }
    }
};

struct EpiScatter {
    static constexpr bool PERM = true;
    unsigned char* Y; const LAS u32x2* etab;
    __device__ __forceinline__ void operator()(const AccT& acc, const Unit& u, int ui, int wr, int wc, int fr, int fq) const {
        const int col0 = (u.pn & 3) * BM + wc * 32 + 8 * fq;
#pragma unroll
        for (int ai = 0; ai < 2; ++ai)
#pragma unroll
            for (int m = 0; m < 4; ++m) { const u32x2 en = etab[ui * 256 + ai * HALF + wr * 64 + m * 16 + fr];
                if (en.x != 0xffffffffu) { const float wt = __uint_as_float(en.y) * 0.5f;
                    unsigned char* rowp = Y + (size_t)en.x * DM + col0;
#pragma unroll
                    for (int bj = 0; bj < 2; ++bj) { const f32x4 a0 = acc[ai][bj][m][0] * wt, a1 = acc[ai][bj][m][1] * wt;
                        u32x2 w; w.x = pk4_fp8(a0[0], a0[1], a0[2], a0[3]); w.y = pk4_fp8(a1[0], a1[1], a1[2], a1[3]); *(u32x2*)(rowp + bj * HALF) = w; } } }
    }
};
}

#define XB_TMO      128
#define XB_XCNT(j)  (256  + 64 * (j))
#define XB_XSUB(j)  (1280 + 64 * (j))
#define XB_XGEN(j)  (2304 + 64 * (j))
#define XB_TOP      3328
#define XB_TOPGEN   3392
#define XCD_BAR_WORDS 3456
#define XB_SPIN_CAP (1u << 18)
__device__ __forceinline__ unsigned xb_ld(unsigned* p)              { return __hip_atomic_load(p, __ATOMIC_RELAXED, __HIP_MEMORY_SCOPE_AGENT); }
__device__ __forceinline__ unsigned xb_add(unsigned* p, unsigned v) { return __hip_atomic_fetch_add(p, v, __ATOMIC_RELAXED, __HIP_MEMORY_SCOPE_AGENT); }
__device__ __forceinline__ unsigned xb_xcc_id() { return (unsigned)__builtin_amdgcn_s_getreg((3 << 11) | 20) & 0xFu; }
#define XB_SPIN(cond, bar) do { unsigned _sp = 0; while (cond) { __builtin_amdgcn_s_sleep(1); \
    if ((++_sp & 255u) == 0u) { if (xb_ld(&(bar)[XB_TMO])) break; if (_sp > XB_SPIN_CAP) { atomicAdd(&(bar)[XB_TMO], 1u); break; } } } } while (0)
struct XcdBarrier { unsigned* bar; unsigned x; volatile LAS unsigned* st; };
__device__ __forceinline__ XcdBarrier xcd_barrier_post(unsigned* bar, volatile LAS unsigned* st) {
    XcdBarrier b; b.bar = bar; b.x = xb_xcc_id(); b.st = st;
    if (threadIdx.x == 0) (void)xb_add(&bar[XB_XCNT(b.x)], 1u);
    return b;
}
__device__ __forceinline__ void xcd_barrier_complete(unsigned* bar, unsigned x, unsigned& nloc, unsigned& nx) {
    const unsigned G = gridDim.x * gridDim.y * gridDim.z;
    unsigned sum, cnt, mine, sp = 0u;
    for (;;) {
        sum = 0u; cnt = 0u; mine = 0u;
#pragma unroll
        for (unsigned j = 0; j < 16; ++j) { const unsigned c = xb_ld(&bar[XB_XCNT(j)]); sum += c; cnt += (c > 0u) ? 1u : 0u; mine = (j == x) ? c : mine; }
        if (sum == G) break;
        __builtin_amdgcn_s_sleep(1);
        if ((++sp & 255u) == 0u) { if (xb_ld(&bar[XB_TMO])) break; if (sp > XB_SPIN_CAP) { atomicAdd(&bar[XB_TMO], 1u); break; } }
    }
    nloc = mine > 0u ? mine : 1u; nx = cnt > 0u ? cnt : 1u;
}
__device__ __forceinline__ void xcd_barrier(const XcdBarrier& b) {
    asm volatile("s_waitcnt vmcnt(0)" ::: "memory");
    __syncthreads();
    if (threadIdx.x == 0) {
        unsigned* bar = b.bar;
        __builtin_amdgcn_s_waitcnt(0);
        unsigned nloc = b.st[0], nx = b.st[1];
        if (nloc == 0u) { xcd_barrier_complete(bar, b.x, nloc, nx); b.st[0] = nloc; b.st[1] = nx; }
        const unsigned old = xb_add(&bar[XB_XSUB(b.x)], 1u);
        const unsigned gen = old / nloc;
        if (old + 1u == (gen + 1u) * nloc) {
            __builtin_amdgcn_fence(__ATOMIC_RELEASE, "agent");
            asm volatile("s_waitcnt vmcnt(0)" ::: "memory");
            const unsigned og = xb_add(&bar[XB_TOP], 1u);
            const unsigned tg = og / nx;
            if (og + 1u == (tg + 1u) * nx) xb_add(&bar[XB_TOPGEN], 1u);
            else XB_SPIN(xb_ld(&bar[XB_TOPGEN]) == tg, bar);
            __builtin_amdgcn_fence(__ATOMIC_ACQUIRE, "agent");
            xb_add(&bar[XB_XGEN(b.x)], 1u);
            asm volatile("s_waitcnt vmcnt(0)" ::: "memory");
        } else {
            XB_SPIN(xb_ld(&bar[XB_XGEN(b.x)]) == gen, bar);
            __builtin_amdgcn_fence(__ATOMIC_ACQUIRE, "agent");
            asm volatile("s_waitcnt vmcnt(0)" ::: "memory");
        }
    }
    __syncthreads();
}

struct Args {
    const float* in[21];
    float* out; unsigned char* ws;
    int ph_lo, ph_hi, li, pad;
};
enum { I_X = 0, I_C, I_GMIX, I_GFFN, I_WADA, I_BADA, I_WIN, I_WSBA, I_GSGU, I_WSP, I_BSP, I_WSGU, I_WOUT, I_WRG, I_BRG, I_WRE, I_BRE, I_WEG, I_WEU, I_WED, I_GFIN };

__device__ __forceinline__ void transpose_tile(const float* src, int N, bf16_t* dst, int ldo, LAS float* scr, int lane) {
#pragma unroll 8
    for (int i = 0; i < 32; ++i) { const int kk = 2 * i + (lane >> 5); scr[kk * 33 + (lane & 31)] = src[(size_t)kk * N + (lane & 31)]; }
    LDS_WAIT(); asm volatile("" ::: "memory");
    const int c = lane & 7;
#pragma unroll
    for (int j = 0; j < 4; ++j) { const int n = (lane >> 3) + 8 * j; const LAS float* s = scr + (8 * c) * 33 + n;
        u32x4 o; o.x = cvtpk(s[0 * 33], s[1 * 33]); o.y = cvtpk(s[2 * 33], s[3 * 33]); o.z = cvtpk(s[4 * 33], s[5 * 33]); o.w = cvtpk(s[6 * 33], s[7 * 33]);
        *(u32x4*)(dst + (size_t)n * ldo + 8 * c) = o; }
    LDS_WAIT(); asm volatile("" ::: "memory");
}

__device__ __forceinline__ void transpose_tile8(const float* src, int N, unsigned char* dst, int ldo, LAS float* scr, int lane, float scale) {
#pragma unroll 8
    for (int i = 0; i < 32; ++i) { const int kk = 2 * i + (lane >> 5); scr[kk * 33 + (lane & 31)] = src[(size_t)kk * N + (lane & 31)]; }
    LDS_WAIT(); asm volatile("" ::: "memory");
    const int c = lane & 3;
#pragma unroll
    for (int j = 0; j < 2; ++j) { const int n = (lane >> 2) + 16 * j; const LAS float* s = scr + (16 * c) * 33 + n;
        u32x4 o;
        o.x = pk4_fp8(s[0 * 33] * scale, s[1 * 33] * scale, s[2 * 33] * scale, s[3 * 33] * scale); o.y = pk4_fp8(s[4 * 33] * scale, s[5 * 33] * scale, s[6 * 33] * scale, s[7 * 33] * scale);
        o.z = pk4_fp8(s[8 * 33] * scale, s[9 * 33] * scale, s[10 * 33] * scale, s[11 * 33] * scale); o.w = pk4_fp8(s[12 * 33] * scale, s[13 * 33] * scale, s[14 * 33] * scale, s[15 * 33] * scale);
        *(u32x4*)(dst + (size_t)n * ldo + 16 * c) = o; }
    LDS_WAIT(); asm volatile("" ::: "memory");
}

__device__ __forceinline__ void transpose_tile_i8(const float* src, int N, unsigned char* dst, int ldo, LAS float* scr, int lane, float scale) {
#pragma unroll 8
    for (int i = 0; i < 32; ++i) { const int kk = 2 * i + (lane >> 5); scr[kk * 33 + (lane & 31)] = src[(size_t)kk * N + (lane & 31)]; }
    LDS_WAIT(); asm volatile("" ::: "memory");
    const int c = lane & 3;
#pragma unroll
    for (int j = 0; j < 2; ++j) { const int n = (lane >> 2) + 16 * j; const LAS float* s = scr + (16 * c) * 33 + n;
        u32x4 o;
        o.x = pk4_i8(s[0 * 33] * scale, s[1 * 33] * scale, s[2 * 33] * scale, s[3 * 33] * scale); o.y = pk4_i8(s[4 * 33] * scale, s[5 * 33] * scale, s[6 * 33] * scale, s[7 * 33] * scale);
        o.z = pk4_i8(s[8 * 33] * scale, s[9 * 33] * scale, s[10 * 33] * scale, s[11 * 33] * scale); o.w = pk4_i8(s[12 * 33] * scale, s[13 * 33] * scale, s[14 * 33] * scale, s[15 * 33] * scale);
        *(u32x4*)(dst + (size_t)n * ldo + 16 * c) = o; }
    LDS_WAIT(); asm volatile("" ::: "memory");
}

__device__ __forceinline__ int crow(int reg, int hh) { return (reg & 3) + 8 * (reg >> 2) + 4 * hh; }
__device__ __forceinline__ bf16x8 pack8(const f32x16& x, int s) {
    u32x4 p; p.x = cvtpk(x[8 * s + 0], x[8 * s + 1]); p.y = cvtpk(x[8 * s + 2], x[8 * s + 3]); p.z = cvtpk(x[8 * s + 4], x[8 * s + 5]); p.w = cvtpk(x[8 * s + 6], x[8 * s + 7]);
    return __builtin_bit_cast(bf16x8, p);
}
typedef short v4i16_t __attribute__((ext_vector_type(4)));
__device__ __forceinline__ s16x4 tr_read(const LAS unsigned char* p) { return __builtin_bit_cast(s16x4, __builtin_amdgcn_ds_read_tr16_b64_v4i16((LAS v4i16_t*)p)); }
__device__ __forceinline__ bf16x8 cat4(s16x4 lo, s16x4 hi) { return (bf16x8){lo[0], lo[1], lo[2], lo[3], hi[0], hi[1], hi[2], hi[3]}; }
#define MFMA32(a, b, c) __builtin_amdgcn_mfma_f32_32x32x16_bf16((a), (b), (c), 0, 0, 0)
constexpr int VROW = 144;

template <bool DIAG>
__device__ __forceinline__ bool attn_iter(bf16x8 (&kf)[4], u32x4 (&vr)[4], const bf16x8 (&qf)[4], const bf16x8 (&ut)[2], f32x16& negc, f32x16 (&ot)[2],
                                          const bf16_t* Kp, const bf16_t* Vp, int sb, LAS unsigned char* vw, const LAS unsigned char* trb, int r, int hh) {
#pragma unroll
    for (int c = 0; c < 4; ++c) *(LAS u32x4*)(vw + 8 * c * VROW) = vr[c];
    f32x16 zero;
#pragma unroll
    for (int i = 0; i < 16; ++i) zero[i] = 0.f;
    f32x16 s = MFMA32(kf[0], qf[0], zero);
#pragma unroll
    for (int kk = 1; kk < 4; ++kk) s = MFMA32(kf[kk], qf[kk], s);
    {
        const int sn = sb >= 64 ? sb - 64 : 0;
#pragma unroll
        for (int kk = 0; kk < 4; ++kk) kf[kk] = *(const bf16x8*)(Kp + (size_t)sn * 64 + 512 * kk);
#pragma unroll
        for (int c = 0; c < 4; ++c) vr[c] = *(const u32x4*)(Vp + (size_t)(sn + 8 * c) * 64);
    }
    f32x16 sp, xx;
#pragma unroll
    for (int i = 0; i < 16; ++i) {
        const float zc = __builtin_amdgcn_fmed3f(s[i], -120.0f, 120.0f);
        float spv = fast_log2(1.0f + fast_exp2(zc));
        float xv = zc - spv;
        if (DIAG && !(crow(i, hh) < r)) { spv = 0.f; xv = -INFINITY; }
        sp[i] = spv; xx[i] = xv;
    }
    const bf16x8 l0 = pack8(sp, 0), l1 = pack8(sp, 1);
    bf16x8 ones;
#pragma unroll
    for (int j = 0; j < 8; ++j) ones[j] = (short)0x3F80;
    f32x16 aft = MFMA32(ut[0], l0, negc); aft = MFMA32(ut[1], l1, aft);
    f32x16 cn = MFMA32(ones, l0, negc); cn = MFMA32(ones, l1, cn);
    f32x16 w;
#pragma unroll
    for (int i = 0; i < 16; ++i) w[i] = fast_exp2(xx[i] - aft[i]);
    const bf16x8 w0 = pack8(w, 0), w1 = pack8(w, 1);
#pragma unroll
    for (int d = 0; d < 2; ++d) {
        const bf16x8 v0 = cat4(tr_read(trb + 64 * d), tr_read(trb + 8 * VROW + 64 * d));
        const bf16x8 v1 = cat4(tr_read(trb + 16 * VROW + 64 * d), tr_read(trb + 24 * VROW + 64 * d));
        ot[d] = MFMA32(v0, w0, ot[d]); ot[d] = MFMA32(v1, w1, ot[d]);
    }
    negc = cn;
    return (sb == 0) || __all(cn[0] > 151.0f);
}
__device__ __forceinline__ void attn_wave_unit(const bf16_t* P, bf16_t* YA, int bh, int qb, LAS unsigned char* vl, int lane) {
    const int b = bh >> 3, h = bh & 7, t0 = qb * 32, r = lane & 31, hh = lane >> 5;
    const size_t rowbase = (size_t)b * SEQ, hbase = (size_t)bh * SEQ;
    const bf16_t* Qp = P + PO_Q + (hbase + t0) * 64 + (hh * 32 + r) * 8;
    const bf16_t* Kp = P + PO_K + hbase * 64 + (hh * 32 + r) * 8;
    const bf16_t* Vp = P + PO_V + (hbase + (lane >> 3)) * 64 + (lane & 7) * 8;
    bf16x8 qf[4];
#pragma unroll
    for (int kk = 0; kk < 4; ++kk) qf[kk] = *(const bf16x8*)(Qp + 512 * kk);
    bf16x8 kfA[4], kfB[4]; u32x4 vrA[4], vrB[4];
    const int t1 = t0 >= 32 ? t0 - 32 : 0;
#pragma unroll
    for (int kk = 0; kk < 4; ++kk) kfA[kk] = *(const bf16x8*)(Kp + (size_t)t0 * 64 + 512 * kk);
#pragma unroll
    for (int c = 0; c < 4; ++c) vrA[c] = *(const u32x4*)(Vp + (size_t)(t0 + 8 * c) * 64);
#pragma unroll
    for (int kk = 0; kk < 4; ++kk) kfB[kk] = *(const bf16x8*)(Kp + (size_t)t1 * 64 + 512 * kk);
#pragma unroll
    for (int c = 0; c < 4; ++c) vrB[c] = *(const u32x4*)(Vp + (size_t)(t1 + 8 * c) * 64);
    bf16x8 ut[2];
#pragma unroll
    for (int s = 0; s < 2; ++s)
#pragma unroll
        for (int j = 0; j < 8; ++j) { const int k = 16 * s + 8 * (j >> 2) + 4 * hh + (j & 3); ut[s][j] = (k > r) ? (short)0x3F80 : (short)0; }
    f32x16 negc, ot[2];
#pragma unroll
    for (int i = 0; i < 16; ++i) { negc[i] = 0.f; ot[0][i] = 0.f; ot[1][i] = 0.f; }
    const int q4 = (lane & 15) >> 2, p4 = lane & 3;
    const LAS unsigned char* trb = vl + (4 * hh + q4) * VROW + 32 * ((lane >> 4) & 1) + 8 * p4;
    LAS unsigned char* vw = vl + (lane >> 3) * VROW + (lane & 7) * 16;
    int sb = t0;
    bool done = attn_iter<true>(kfA, vrA, qf, ut, negc, ot, Kp, Vp, sb, vw, trb, r, hh);
    while (!done) {
        sb -= 32; done = attn_iter<false>(kfB, vrB, qf, ut, negc, ot, Kp, Vp, sb, vw, trb, r, hh);
        if (done) break;
        sb -= 32; done = attn_iter<false>(kfA, vrA, qf, ut, negc, ot, Kp, Vp, sb, vw, trb, r, hh);
    }
#pragma unroll
    for (int kk = 0; kk < 4; ++kk) asm volatile("" :: "v"(kfA[kk]), "v"(kfB[kk]), "v"(vrA[kk]), "v"(vrB[kk]));
#pragma unroll
    for (int d = 0; d < 2; ++d)
#pragma unroll
        for (int g4 = 0; g4 < 4; ++g4) { u32x2 o; o.x = cvtpk(ot[d][4 * g4 + 0], ot[d][4 * g4 + 1]); o.y = cvtpk(ot[d][4 * g4 + 2], ot[d][4 * g4 + 3]);
            *(LAS u32x2*)(vl + r * VROW + (32 * d + 8 * g4 + 4 * hh) * 2) = o; }
    bf16_t* op = YA + (rowbase + t0 + (lane >> 3)) * DM + h * 64 + (lane & 7) * 8;
#pragma unroll
    for (int c = 0; c < 4; ++c) { const u32x4 o = *(const LAS u32x4*)(vw + 8 * c * VROW); *(u32x4*)(op + (size_t)(8 * c) * DM) = o; }
}

__device__ __forceinline__ void sgu_unit(const bf16_t* P, bf16_t* YB, const bf16_t* Wsp, const float* g_sgu, const float* b_sp, const f32x2* svst, int ch, int g, LAS unsigned char* vt, int lane) {
    const size_t R0 = (size_t)ch * 128;
    LAS f32x2* st = (LAS f32x2*)(vt + 128 * VROW);
    const int chunk = lane & 7;
    u32x4 vv[16];
#pragma unroll
    for (int c16 = 0; c16 < 16; ++c16) vv[c16] = *(const u32x4*)(P + PO_SV + (R0 + c16 * 8 + (lane >> 3)) * 512 + 64 * g + 8 * chunk);
#pragma unroll
    for (int tt = 0; tt < 2; ++tt) { const f32x4* sp = (const f32x4*)(svst + (R0 + lane + 64 * tt) * 8); float s1 = 0.f, s2 = 0.f;
#pragma unroll
        for (int j = 0; j < 4; ++j) { const f32x4 t4 = sp[j]; s1 += t4.x + t4.z; s2 += t4.y + t4.w; }
        const float mean = s1 * (1.0f / 512.0f), var = __builtin_fmaxf(s2 * (1.0f / 512.0f) - mean * mean, 0.f);
        st[lane + 64 * tt] = (f32x2){mean, 1.0f / __builtin_sqrtf(var + EPS)}; }
    {
        const u32x4 ga = *(const u32x4*)(g_sgu + 64 * g + 8 * chunk), gb = *(const u32x4*)(g_sgu + 64 * g + 8 * chunk + 4);
        const float gv[8] = {__uint_as_float(ga.x), __uint_as_float(ga.y), __uint_as_float(ga.z), __uint_as_float(ga.w), __uint_as_float(gb.x), __uint_as_float(gb.y), __uint_as_float(gb.z), __uint_as_float(gb.w)};
#pragma unroll
        for (int c16 = 0; c16 < 16; ++c16) { const int s = c16 * 8 + (lane >> 3);
            u32x4 v = vv[c16];
            asm volatile("" : "+v"(v));
            const f32x2 ms = st[s];
            float f[8] = {bf_lo(v.x), bf_hi(v.x), bf_lo(v.y), bf_hi(v.y), bf_lo(v.z), bf_hi(v.z), bf_lo(v.w), bf_hi(v.w)};
#pragma unroll
            for (int j = 0; j < 8; ++j) f[j] = (f[j] - ms.x) * ms.y * gv[j];
            u32x4 o; o.x = cvtpk(f[0], f[1]); o.y = cvtpk(f[2], f[3]); o.z = cvtpk(f[4], f[5]); o.w = cvtpk(f[6], f[7]);
            *(LAS u32x4*)(vt + s * VROW + chunk * 16) = o; }
    }
    asm volatile("" ::: "memory");
    const int r = lane & 31, hh = lane >> 5, q4 = (lane & 15) >> 2, p4 = lane & 3;
    const LAS unsigned char* trb = vt + (8 * hh + q4) * VROW + 32 * ((lane >> 4) & 1) + 8 * p4;
    const bf16_t* wp = Wsp + (size_t)g * (4 * 8 * 512) + lane * 8;
    LAS unsigned char* stg = vt + 64 * VROW;
#pragma unroll
    for (int tq = 0; tq < 2; ++tq) {
        const int tp = 1 - tq;
        const bf16_t* wq = wp; asm volatile("" : "+v"(wq));
        f32x16 acc[2][2];
#pragma unroll
        for (int tl = 0; tl < 2; ++tl)
#pragma unroll
            for (int cb = 0; cb < 2; ++cb)
#pragma unroll
                for (int i = 0; i < 16; ++i) acc[tl][cb][i] = 0.f;
        u32x2 uu[2][2][4]; float bs[2];
#pragma unroll
        for (int tl = 0; tl < 2; ++tl) { const int tb = 2 * tp + tl; bs[tl] = b_sp[g * 128 + 32 * tb + r];
            const bf16_t* up = P + PO_U + (((R0 >> 5) + tb) * 64 + 8 * g) * 256 + r * 8 + 4 * hh;
#pragma unroll
            for (int cb = 0; cb < 2; ++cb)
#pragma unroll
                for (int g4 = 0; g4 < 4; ++g4) uu[tl][cb][g4] = *(const u32x2*)(up + (4 * cb + g4) * 256); }
#pragma unroll
        for (int ss = 0; ss < 8; ++ss) if (ss < 4 * tp + 4) {
            bf16x8 af[2];
#pragma unroll
            for (int cb = 0; cb < 2; ++cb) af[cb] = cat4(tr_read(trb + 16 * ss * VROW + 64 * cb), tr_read(trb + (16 * ss + 4) * VROW + 64 * cb));
#pragma unroll
            for (int tl = 0; tl < 2; ++tl) { const int tb = 2 * tp + tl; if (tb >= (ss >> 1)) {
                const bf16x8 bfr = *(const bf16x8*)(wq + (tb * 8 + ss) * 512);
#pragma unroll
                for (int cb = 0; cb < 2; ++cb) acc[tl][cb] = MFMA32(af[cb], bfr, acc[tl][cb]);
            } }
        }
#pragma unroll
        for (int tl = 0; tl < 2; ++tl)
#pragma unroll
            for (int cb = 0; cb < 2; ++cb)
#pragma unroll
                for (int g4 = 0; g4 < 4; ++g4) { const u32x2 u2 = uu[tl][cb][g4];
                    const float y0 = bf_lo(u2.x) * (acc[tl][cb][4 * g4 + 0] + bs[tl]), y1 = bf_hi(u2.x) * (acc[tl][cb][4 * g4 + 1] + bs[tl]);
                    const float y2 = bf_lo(u2.y) * (acc[tl][cb][4 * g4 + 2] + bs[tl]), y3 = bf_hi(u2.y) * (acc[tl][cb][4 * g4 + 3] + bs[tl]);
                    u32x2 o; o.x = cvtpk(y0, y1); o.y = cvtpk(y2, y3);
                    *(LAS u32x2*)(stg + (32 * tl + r) * VROW + (32 * cb + 8 * g4 + 4 * hh) * 2) = o; }
        bf16_t* yp = YB + (R0 + 64 * tp + (lane >> 3)) * DM + 64 * g + (lane & 7) * 8;
#pragma unroll
        for (int j = 0; j < 8; ++j) { const u32x4 o = *(const LAS u32x4*)(stg + (8 * j + (lane >> 3)) * VROW + (lane & 7) * 16); *(u32x4*)(yp + (size_t)(8 * j) * DM) = o; }
        asm volatile("" ::: "memory");
    }
}

__device__ __forceinline__ void bfly_argmax16(float& v, int& idx) {
#pragma unroll
    for (int o = 1; o < 16; o <<= 1) { const float ov = __shfl_xor(v, o); const int oi = __shfl_xor(idx, o);
        const bool take = (ov > v) || (ov == v && oi < idx); v = take ? ov : v; idx = take ? oi : idx; }
}
__device__ __forceinline__ float bfly_sum16(float v) {
#pragma unroll
    for (int o = 1; o < 16; o <<= 1) v += __shfl_xor(v, o);
    return v;
}
#define MFMA16(a, b, c) __builtin_amdgcn_mfma_f32_16x16x32_bf16((a), (b), (c), 0, 0, 0)

__global__ void __launch_bounds__(NWAVES * 64, 2) fwd_kernel(Args args) {
    extern __shared__ __attribute__((aligned(16))) unsigned char lds_raw[];
    LAS unsigned char* lds = (LAS unsigned char*)lds_raw;
    const int tid = threadIdx.x, lane = tid & 63, wave = __builtin_amdgcn_readfirstlane(tid >> 6);
    const int G = gridDim.x, bx = blockIdx.x;
    const int vcu = (G % 8 == 0) ? (bx % 8) * (G / 8) + bx / 8 : bx;
    unsigned char* ws = args.ws;
    gu32* ctl = (gu32*)(ws + WS_CTL);
    volatile LAS unsigned* MISC = (volatile LAS unsigned*)(lds + MISC_OFF);
    for (int u = tid; u < 64; u += NWAVES * 64) MISC[u] = 0u;
    __syncthreads();
    XcdBarrier bar = xcd_barrier_post((unsigned*)(ctl + CW_BAR) + args.li * XCD_BAR_WORDS, MISC + 8);
    const int lo = args.ph_lo, hi = args.ph_hi;
#define IN(k) (lo <= (k) && (k) < hi)
#define SEAM(k) do { if (IN(k) && IN((k) + 1)) xcd_barrier(bar); } while (0)

    const float* X = args.in[I_X];
    float* mod = (float*)(ws + WS_MOD);
    bf16_t* XN = (bf16_t*)(ws + WS_XN);
    bf16_t* Pb = (bf16_t*)(ws + WS_P);
    bf16_t* YAB = (bf16_t*)(ws + WS_YA);
    bf16_t* Hh = YAB;
    float* stats = (float*)(ws + WS_STATS);
    u32x2* list = (u32x2*)(ws + WS_LIST);
    const int gw = vcu * NWAVES + wave, NGW = G * NWAVES;

    if (IN(0)) {
        {
            LAS float* cact = (LAS float*)lds;
            LAS float* part = (LAS float*)(lds + 32768);
            bool filled = false;
            for (int cg = bx; cg < 192; cg += G) {
                if (!filled) { for (int i = tid; i < 8192; i += NWAVES * 64) { const float v = args.in[I_C][i]; cact[i] = v * fast_rcp(1.0f + __expf(-v)); } filled = true; }
                __syncthreads();
                float a[8];
#pragma unroll
                for (int b = 0; b < 8; ++b) a[b] = 0.f;
                const int kbase = 128 * wave + 64 * (lane >> 5);
                const float* wp = args.in[I_WADA] + (size_t)kbase * 6144 + 32 * cg + (lane & 31);
#pragma unroll 16
                for (int k = 0; k < 64; ++k) { const float wv = wp[(size_t)k * 6144];
#pragma unroll
                    for (int b = 0; b < 8; ++b) a[b] += cact[b * 1024 + kbase + k] * wv; }
#pragma unroll
                for (int b = 0; b < 8; ++b) part[(wave * 8 + b) * 64 + lane] = a[b];
                __syncthreads();
                if (tid < 256) { const int b = tid >> 5, j = tid & 31; float s = args.in[I_BADA][32 * cg + j];
#pragma unroll
                    for (int w = 0; w < 8; ++w) s += part[(w * 8 + b) * 64 + j] + part[(w * 8 + b) * 64 + 32 + j];
                    mod[b * 6144 + 32 * cg + j] = s; }
                __syncthreads();
            }
        }
        {
            LAS float* scr = (LAS float*)(lds + 49152 + wave * 8448);
            constexpr int I_IN = 16 * 144, I_A = 8 * 32, I_B = 8 * 32, I_O = 16 * 32, I_E = 768;
            constexpr int NITEMS = I_IN + I_A + I_B + I_O + NEXP * I_E;
            for (int it = gw; it < NITEMS; it += NGW) {
                int r = it;
                if (r < I_IN) { const int kb = r / 144, nb = r % 144; int drow = 32 * nb;
                    if (drow >= C_GA) { const int isb = drow >= C_GB, a = drow - (isb ? C_GB : C_GA); drow = C_GA + 256 * (a >> 7) + 128 * isb + (a & 127); }
                    transpose_tile_i8(args.in[I_WIN] + (size_t)(64 * kb) * LDP + 32 * nb, LDP, (unsigned char*)(ws + WS_WIN) + (size_t)drow * 1024 + 64 * kb, 1024, scr, lane, QS_WIN);
                    continue; } r -= I_IN;
                if (r < I_A) { const int kb = r / 32, nb = r % 32; transpose_tile(args.in[I_WSBA] + (size_t)(64 * kb) * 1024 + 32 * nb, 1024, (bf16_t*)(ws + WS_WA) + (size_t)(32 * nb) * 1024 + 64 * kb, 1024, scr, lane); continue; } r -= I_A;
                if (r < I_B) { const int kb = r / 32, nb = r % 32; transpose_tile(args.in[I_WSGU] + (size_t)(64 * kb) * 1024 + 32 * nb, 1024, (bf16_t*)(ws + WS_WA) + (size_t)(32 * nb) * 1024 + 512 + 64 * kb, 1024, scr, lane); continue; } r -= I_B;
                if (r < I_O) { const int kb = r / 32, nb = r % 32; transpose_tile_i8(args.in[I_WOUT] + (size_t)(64 * kb) * 1024 + 32 * nb, 1024, (unsigned char*)(ws + WS_WO) + (size_t)(32 * nb) * 1024 + 64 * kb, 1024, scr, lane, QS_WOUT); continue; } r -= I_O;
                const int e = r / I_E, q = r % I_E;
                if (q < 512) {
                    const int up = q >> 8, qq = q & 255, kb = qq / 16, nb = qq % 16, n0 = 32 * nb;
                    const float* src = args.in[up ? I_WEU : I_WEG] + (size_t)e * 1024 * 512 + (size_t)(64 * kb) * 512 + n0;
                    const int orow = 256 * (n0 >> 7) + 128 * up + (n0 & 127);
                    transpose_tile8(src, 512, (unsigned char*)(ws + WS_BT1) + ((size_t)e * 1024 + orow) * 1024 + 64 * kb, 1024, scr, lane, 32.0f);
                } else {
                    const int qq = q - 512, kb = qq / 32, nb = qq % 32;
                    const float* src = args.in[I_WED] + (size_t)e * 512 * 1024 + (size_t)(64 * kb) * 1024 + 32 * nb;
                    transpose_tile8(src, 1024, (unsigned char*)(ws + WS_BT2) + ((size_t)e * 1024 + 32 * nb) * 512 + 64 * kb, 512, scr, lane, 32.0f);
                }
            }
        }
        { bf16_t* wsp = (bf16_t*)(ws + WS_WSP);
            for (int i = bx * NWAVES * 64 + tid; i < 8 * 128 * 128 / 2; i += G * NWAVES * 64) { const int e0 = 2 * i, j = e0 & 7, ln = (e0 >> 3) & 63, ss = (e0 >> 9) & 7, tb = (e0 >> 12) & 3, g = e0 >> 14;
                const int t = 32 * tb + (ln & 31), s = 16 * ss + 8 * (ln >> 5) + j;
                const f32x2 w = *(const f32x2*)(args.in[I_WSP] + ((size_t)g * 128 + t) * 128 + s); ((unsigned*)wsp)[i] = cvtpk(s <= t ? w.x : 0.f, (s + 1) <= t ? w.y : 0.f); } }
        { bf16_t* wr = (bf16_t*)(ws + WS_WR);
            for (int i = bx * NWAVES * 64 + tid; i < 36 * 1024; i += G * NWAVES * 64) { const int c = i >> 10, k = i & 1023;
                const float w = (c < 32) ? args.in[I_WRE][k * 32 + c] : args.in[I_WRG][k * 4 + (c - 32)];
                const unsigned hb = cvtpk(w, 0.f) & 0xffffu; const float hf = __uint_as_float(hb << 16);
                wr[i] = (bf16_t)hb; wr[36 * 1024 + i] = (bf16_t)(cvtpk(w - hf, 0.f) & 0xffffu); } }
    }
    SEAM(0);

    if (IN(1)) {
        const float* gm = args.in[I_GMIX];
        for (int m = 2 * gw; m < NTOK; m += 2 * NGW) {
            const int b = m / SEQ; const float* sh = mod + b * 6144; const float* sc = sh + DM;
            const f32x4* xr = (const f32x4*)(X + (size_t)m * DM) + lane;
            f32x4 v[2][4]; float s0 = 0.f, s1 = 0.f;
#pragma unroll
            for (int j = 0; j < 4; ++j) { v[0][j] = xr[64 * j]; v[1][j] = xr[256 + 64 * j]; }
#pragma unroll
            for (int j = 0; j < 4; ++j) { s0 += (v[0][j].x * v[0][j].x + v[0][j].y * v[0][j].y) + (v[0][j].z * v[0][j].z + v[0][j].w * v[0][j].w);
                s1 += (v[1][j].x * v[1][j].x + v[1][j].y * v[1][j].y) + (v[1][j].z * v[1][j].z + v[1][j].w * v[1][j].w); }
            const float r0 = 1.0f / __builtin_sqrtf(wave_sum(s0) * (1.0f / DM) + EPS), r1 = 1.0f / __builtin_sqrtf(wave_sum(s1) * (1.0f / DM) + EPS);
            unsigned* n8 = (unsigned*)((unsigned char*)XN + (size_t)m * DM) + lane;
#pragma unroll
            for (int j = 0; j < 4; ++j) { const int c = 4 * lane + 256 * j; const f32x4 g4 = *(const f32x4*)(gm + c), s4 = *(const f32x4*)(sc + c), h4 = *(const f32x4*)(sh + c);
                const f32x4 gs = g4 * (s4 + 1.0f);
                const f32x4 n0 = (v[0][j] * r0) * gs + h4, n1 = (v[1][j] * r1) * gs + h4;
                n8[64 * j] = pk4_i8(QS_N * n0.x, QS_N * n0.y, QS_N * n0.z, QS_N * n0.w); n8[256 + 64 * j] = pk4_i8(QS_N * n1.x, QS_N * n1.y, QS_N * n1.z, QS_N * n1.w); }
        }
    }
    SEAM(1);

    if (IN(2)) {
        pg8::Gemm g{XN, (const bf16_t*)(ws + WS_WIN), DM, DM, DM}; pg8::StaticOrder S; S.init(NTOK, LDP, G, bx);
        pg8::EpiProj E{Pb, (f32x2*)(ws + WS_STATS)};
        pg8::gemm_phase<pg8::EpiProj, pg8::StaticOrder, true, false, false, false, true>(lds, g, S, E, nullptr);
    }
    SEAM(2);

    if (IN(3)) {
        LAS unsigned char* wl = lds + wave * (128 * VROW + 1024);
        volatile LAS unsigned* qctr = MISC + 16;
        if (tid == 0) { qctr[0] = 0u; qctr[1] = 0u; }
        __syncthreads();
        const int n_att = (NB * 8 * (SEQ / 32) + G - 1) / G;
        for (;;) {
            int k = 0;
            if (lane == 0) k = (int)__hip_atomic_fetch_add((LAS unsigned*)qctr, 1u, __ATOMIC_RELAXED, __HIP_MEMORY_SCOPE_WORKGROUP);
            k = __builtin_amdgcn_readfirstlane(k);
            if (k >= n_att) break;
            const int bhh = 8 * (vcu & 7) + (k >> 3), qbb = 8 * (vcu >> 3) + (k & 7);
            attn_wave_unit(Pb, YAB, bhh, qbb, wl, lane);
        }
        const int n_sgu = ((NTOK / 128 + G - 1) / G) * 8;
        for (;;) {
            int k = 0;
            if (lane == 0) k = (int)__hip_atomic_fetch_add((LAS unsigned*)(qctr + 1), 1u, __ATOMIC_RELAXED, __HIP_MEMORY_SCOPE_WORKGROUP);
            k = __builtin_amdgcn_readfirstlane(k);
            const int ch = vcu + (k >> 3) * G;
            if (k >= n_sgu || ch >= NTOK / 128) break;
            sgu_unit(Pb, YAB + 512, (const bf16_t*)(ws + WS_WSP), args.in[I_GSGU], args.in[I_BSP], (const f32x2*)(ws + WS_STATS), ch, k & 7, wl, lane);
        }
        __syncthreads();
    }
    SEAM(3);

    if (IN(4)) {
        pg8::Gemm g{YAB, (const bf16_t*)(ws + WS_WA), DM, DM, DM}; pg8::StaticOrder S; S.init(NTOK, DM, G, bx);
        pg8::EpiMerge E{(unsigned char*)XN, Pb};
        pg8::gemm_phase<pg8::EpiMerge, pg8::StaticOrder, true, false, true>(lds, g, S, E, nullptr);
    }
    SEAM(4);

    if (IN(5)) {
        pg8::Gemm g{XN, (const bf16_t*)(ws + WS_WO), DM, DM, DM}; pg8::StaticOrder S; S.init(NTOK, DM, G, bx);
        { LAS unsigned* gt5 = (LAS unsigned*)(lds + GTAB_OFF);
            pg8::Unit uu; for (int i = 0; i < 9 && S.next(i, uu); ++i) if (tid < 256) gt5[i * 256 + tid] = (unsigned)(uu.pm * 256 + tid) * (unsigned)DM;
            __syncthreads(); }
        pg8::EpiResid E{X, Hh, mod, stats};
        pg8::gemm_phase<pg8::EpiResid, pg8::StaticOrder, true, true, false, false, true>(lds, g, S, E, (const LAS unsigned*)(lds + GTAB_OFF));
    }
    SEAM(5);

    if (IN(6)) {
        { const u32x4* src = (const u32x4*)(ws + WS_WR);
            for (int i = tid; i < 2 * 36 * 128; i += NWAVES * 64) { const int row = i >> 7, chn = i & 127;
                *(LAS u32x4*)(lds + row * 2048 + ((chn ^ (row % 36 & 15)) << 4)) = src[i]; } }
        const int tpb = (NTOK / 16 + G - 1) / G;
        LAS float* A1 = (LAS float*)(lds + 147456); LAS float* A0 = A1 + DM;
        LAS u32x2* rbuf = (LAS u32x2*)(lds + 155648);
        LAS unsigned* lcnt = (LAS unsigned*)(lds + 159744); LAS unsigned* lbase = lcnt + NEXP;
        if (tid < NEXP) lcnt[tid] = 0u;
        { const int b0 = (vcu * tpb * 16) / SEQ; const float* sh = mod + b0 * 6144 + 3 * DM; const float* sc = sh + DM;
            for (int k = tid; k < DM; k += NWAVES * 64) { A1[k] = args.in[I_GFFN][k] * (1.0f + sc[k]); A0[k] = sh[k]; } }
        __syncthreads();
        const int rr = lane & 15, q = lane >> 4;
        for (int ti = wave; ti < tpb; ti += NWAVES) {
            const int task = vcu * tpb + ti; if (task >= NTOK / 16) break;
            const int R0 = task * 16, row = R0 + rr;
            float ssq = 0.f;
            { const f32x4* sp = (const f32x4*)(stats + (size_t)row * 16);
#pragma unroll
                for (int j = 0; j < 4; ++j) { const f32x4 t4 = sp[j]; ssq += (t4.x + t4.y) + (t4.z + t4.w); } }
            const float rstd = 1.0f / __builtin_sqrtf(ssq * (1.0f / DM) + EPS);
            f32x4 a0 = {0.f, 0.f, 0.f, 0.f}, a1 = a0, a2 = a0;
            const bf16_t* hp = Hh + (size_t)row * DM + 8 * q;
            unsigned char* np = (unsigned char*)XN + (size_t)row * DM + 8 * q;
            const int sw = rr;
            for (int kb = 0; kb < 4; ++kb) {
                u32x4 hq[8];
#pragma unroll
                for (int j = 0; j < 8; ++j) hq[j] = *(const u32x4*)(hp + 32 * (8 * kb + j));
#pragma unroll
                for (int j = 0; j < 8; ++j) {
                const int kk = 8 * kb + j, k0 = 32 * kk + 8 * q;
                const u32x4 hv = hq[j];
                const f32x4 h0 = {bf_lo(hv.x), bf_hi(hv.x), bf_lo(hv.y), bf_hi(hv.y)}, h1 = {bf_lo(hv.z), bf_hi(hv.z), bf_lo(hv.w), bf_hi(hv.w)};
                const f32x4 m0 = *(const LAS f32x4*)(A1 + k0), m1 = *(const LAS f32x4*)(A1 + k0 + 4);
                const f32x4 s0 = *(const LAS f32x4*)(A0 + k0), s1 = *(const LAS f32x4*)(A0 + k0 + 4);
                const f32x4 n0 = (h0 * rstd) * m0 + s0, n1 = (h1 * rstd) * m1 + s1;
                u32x4 hi4; hi4.x = cvtpk(n0.x, n0.y); hi4.y = cvtpk(n0.z, n0.w); hi4.z = cvtpk(n1.x, n1.y); hi4.w = cvtpk(n1.z, n1.w);
                { u32x2 n8; n8.x = pk4_fp8(n0.x, n0.y, n0.z, n0.w); n8.y = pk4_fp8(n1.x, n1.y, n1.z, n1.w); *(u32x2*)(np + 32 * kk) = n8; }
                u32x4 lo4; lo4.x = cvtpk(n0.x - bf_lo(hi4.x), n0.y - bf_hi(hi4.x)); lo4.y = cvtpk(n0.z - bf_lo(hi4.y), n0.w - bf_hi(hi4.y));
                lo4.z = cvtpk(n1.x - bf_lo(hi4.z), n1.y - bf_hi(hi4.z)); lo4.w = cvtpk(n1.z - bf_lo(hi4.w), n1.w - bf_hi(hi4.w));
                const bf16x8 Ah = __builtin_bit_cast(bf16x8, hi4), Al = __builtin_bit_cast(bf16x8, lo4);
                const int chn = ((4 * kk + q) ^ sw) << 4;
                const bf16x8 b0h = *(const LAS bf16x8*)(lds + (rr) * 2048 + chn), b0l = *(const LAS bf16x8*)(lds + (36 + rr) * 2048 + chn);
                const bf16x8 b1h = *(const LAS bf16x8*)(lds + (16 + rr) * 2048 + chn), b1l = *(const LAS bf16x8*)(lds + (52 + rr) * 2048 + chn);
                bf16x8 b2h = *(const LAS bf16x8*)(lds + (32 + (rr & 3)) * 2048 + (((4 * kk + q) ^ (rr & 3)) << 4)), b2l = *(const LAS bf16x8*)(lds + (68 + (rr & 3)) * 2048 + (((4 * kk + q) ^ (rr & 3)) << 4));
                if (rr >= 4) { b2h = (bf16x8){0, 0, 0, 0, 0, 0, 0, 0}; b2l = b2h; }
                a0 = MFMA16(Ah, b0h, a0); a0 = MFMA16(Al, b0h, a0); a0 = MFMA16(Ah, b0l, a0);
                a1 = MFMA16(Ah, b1h, a1); a1 = MFMA16(Al, b1h, a1); a1 = MFMA16(Ah, b1l, a1);
                a2 = MFMA16(Ah, b2h, a2); a2 = MFMA16(Al, b2h, a2); a2 = MFMA16(Ah, b2l, a2);
                }
            }
            const float brg = (rr < 4) ? args.in[I_BRG][rr] : 0.f;
            const float bre0 = args.in[I_BRE][rr], bre1 = args.in[I_BRE][16 + rr];
#pragma unroll
            for (int reg = 0; reg < 4; ++reg) {
                float gl = (rr < 4) ? (a2[reg] + brg) : -INFINITY; const float gl_own = gl; int gi = rr;
                bfly_argmax16(gl, gi);
                const float ge = (rr < 4) ? __expf(gl_own - gl) : 0.f;
                const float gwt = 1.0f / bfly_sum16(ge);
                const int ct = gi >> 1, half = gi & 1;
                const float ev_own = (ct ? (a1[reg] + bre1) : (a0[reg] + bre0));
                const bool valid = ((rr >> 3) == half);
                float m1 = valid ? ev_own : -INFINITY; int i1 = rr & 7;
                bfly_argmax16(m1, i1);
                float m2 = (valid && (rr & 7) != i1) ? ev_own : -INFINITY; int i2 = rr & 7;
                bfly_argmax16(m2, i2);
                const float e2 = __expf(m2 - m1), p1 = 1.0f / (1.0f + e2), p2 = e2 * p1;
                if (rr == 0) {
                    const int rl = ti * 16 + 4 * q + reg;
                    const int e1 = gi * 8 + i1, e2i = gi * 8 + i2;
                    const unsigned s1 = __hip_atomic_fetch_add(lcnt + e1, 1u, __ATOMIC_RELAXED, __HIP_MEMORY_SCOPE_WORKGROUP);
                    const unsigned s2 = __hip_atomic_fetch_add(lcnt + e2i, 1u, __ATOMIC_RELAXED, __HIP_MEMORY_SCOPE_WORKGROUP);
                    rbuf[2 * rl] = (u32x2){((unsigned)e1 << 16) | s1, __float_as_uint(p1 * gwt)};
                    rbuf[2 * rl + 1] = (u32x2){((unsigned)e2i << 16) | s2, __float_as_uint(p2 * gwt)};
                }
            }
        }
        __syncthreads();
        if (tid < NEXP) lbase[tid] = __hip_atomic_fetch_add((unsigned*)(ctl + CW_CNT + 64 * tid), lcnt[tid], __ATOMIC_RELAXED, __HIP_MEMORY_SCOPE_AGENT);
        __syncthreads();
        for (int t = tid; t < tpb * 32; t += NWAVES * 64) { const int rl = t >> 1; const int task = vcu * tpb + (rl >> 4);
            if (task < NTOK / 16) { const u32x2 en = rbuf[t]; const unsigned e = en.x >> 16, slot = en.x & 0xffffu;
                list[(size_t)e * NTOK + lbase[e] + slot] = (u32x2){(unsigned)(task * 16 + (rl & 15)) * 2u + (unsigned)(t & 1), en.y}; } }
        __syncthreads();
    }
    SEAM(6);

    LAS int* utab = (LAS int*)(lds + UTAB_OFF);
    LAS int* moeb = (LAS int*)(lds + MOEB_OFF);
    LAS unsigned* gtab = (LAS unsigned*)(lds + GTAB_OFF);
    int n_units = 0;
    if (IN(7) || IN(8)) {
        if (tid < NEXP) moeb[33 + tid] = (int)__hip_atomic_load((unsigned*)(ctl + CW_CNT + 64 * tid), __ATOMIC_RELAXED, __HIP_MEMORY_SCOPE_AGENT);
        __syncthreads();
        if (tid == 0) { int acc = 0;
            for (int e = 0; e < NEXP; ++e) { moeb[e] = acc; acc += (moeb[33 + e] + 255) >> 8; }
            moeb[32] = acc; }
        __syncthreads();
        const int total4 = moeb[32] * 4;
        if (tid < 9) { const int L = tid * G + vcu; int pm = 0, pn = 0;
            if (L < total4) { const int rb = L >> 2; int e = 0; for (int k = 1; k < NEXP; ++k) e += (rb >= moeb[k]) ? 1 : 0; pm = rb; pn = e * 4 + (L & 3); }
            utab[2 * tid] = pm; utab[2 * tid + 1] = pn; }
        for (int i = 0; i < 9; ++i) if (i * G + vcu < total4) n_units = i + 1;
        __syncthreads();
    }

    if (IN(7)) {
        for (int t = tid; t < n_units * 256; t += NWAVES * 64) { const int i = t >> 8, rw = t & 255; const int pm = utab[2 * i], e = utab[2 * i + 1] >> 2; const int idx = (pm - moeb[e]) * 256 + rw;
            unsigned tok = 0u; if (idx < moeb[33 + e]) tok = list[(size_t)e * NTOK + idx].x >> 1; gtab[t] = tok * (unsigned)DM; }
        __syncthreads();
        pg8::Gemm g{XN, (const bf16_t*)(ws + WS_BT1), DM, DM, DM}; pg8::TableOrder S{utab, n_units};
        pg8::EpiSwiglu E{(unsigned char*)(ws + WS_HID)};
        pg8::gemm_phase<pg8::EpiSwiglu, pg8::TableOrder, true, true, false, true>(lds, g, S, E, gtab);
    }
    SEAM(7);

    if (IN(8)) {
        LAS u32x2* etab = (LAS u32x2*)(lds + ETAB_OFF);
        for (int t = tid; t < n_units * 256; t += NWAVES * 64) { const int i = t >> 8, rw = t & 255; const int pm = utab[2 * i], e = utab[2 * i + 1] >> 2; const int idx = (pm - moeb[e]) * 256 + rw;
            u32x2 en = {0xffffffffu, 0u}; if (idx < moeb[33 + e]) en = list[(size_t)e * NTOK + idx]; etab[t] = en;
            gtab[t] = (unsigned)(pm * 256 + rw) * (unsigned)DEXP; }
        __syncthreads();
        pg8::Gemm g{(const bf16_t*)(ws + WS_HID), (const bf16_t*)(ws + WS_BT2), DEXP, DEXP, DEXP}; pg8::TableOrder S{utab, n_units};
        pg8::EpiScatter E{(unsigned char*)(ws + WS_YBUF), etab};
        pg8::gemm_phase<pg8::EpiScatter, pg8::TableOrder, true, true, false, true>(lds, g, S, E, gtab);
    }
    SEAM(8);

    if (IN(9)) {
        const float* gfin = args.in[I_GFIN];
        const unsigned char* Yb = (const unsigned char*)(ws + WS_YBUF);
        const unsigned tmo = __hip_atomic_load((unsigned*)(ctl + CW_BAR) + XB_TMO, __ATOMIC_RELAXED, __HIP_MEMORY_SCOPE_AGENT);
        for (int m = 2 * gw; m < NTOK; m += 2 * NGW) {
            const int b = m / SEQ; const float* gt = mod + b * 6144 + 5 * DM;
            u32x4 hv[2][2]; u32x2 ya[2][2], yb[2][2];
#pragma unroll
            for (int rr = 0; rr < 2; ++rr)
#pragma unroll
                for (int j = 0; j < 2; ++j) { const int c = 8 * lane + 512 * j;
                    hv[rr][j] = *(const u32x4*)(Hh + (size_t)(m + rr) * DM + c);
                    ya[rr][j] = *(const u32x2*)(Yb + (size_t)(2 * (m + rr)) * DM + c); yb[rr][j] = *(const u32x2*)(Yb + (size_t)(2 * (m + rr) + 1) * DM + c); }
            float v[2][16]; float ss[2] = {0.f, 0.f};
#pragma unroll
            for (int j = 0; j < 2; ++j) { const int c = 8 * lane + 512 * j;
                const f32x4 g0 = *(const f32x4*)(gt + c) * 0.0625f, g1 = *(const f32x4*)(gt + c + 4) * 0.0625f;
#pragma unroll
                for (int rr = 0; rr < 2; ++rr) { const u32x4 h = hv[rr][j]; const u32x2 a = ya[rr][j], bq = yb[rr][j];
                    const f32x2 a01 = __builtin_amdgcn_cvt_pk_f32_fp8((int)a.x, false), a23 = __builtin_amdgcn_cvt_pk_f32_fp8((int)a.x, true), a45 = __builtin_amdgcn_cvt_pk_f32_fp8((int)a.y, false), a67 = __builtin_amdgcn_cvt_pk_f32_fp8((int)a.y, true);
                    const f32x2 b01 = __builtin_amdgcn_cvt_pk_f32_fp8((int)bq.x, false), b23 = __builtin_amdgcn_cvt_pk_f32_fp8((int)bq.x, true), b45 = __builtin_amdgcn_cvt_pk_f32_fp8((int)bq.y, false), b67 = __builtin_amdgcn_cvt_pk_f32_fp8((int)bq.y, true);
                    v[rr][8 * j + 0] = bf_lo(h.x) + g0.x * (a01[0] + b01[0]); v[rr][8 * j + 1] = bf_hi(h.x) + g0.y * (a01[1] + b01[1]);
                    v[rr][8 * j + 2] = bf_lo(h.y) + g0.z * (a23[0] + b23[0]); v[rr][8 * j + 3] = bf_hi(h.y) + g0.w * (a23[1] + b23[1]);
                    v[rr][8 * j + 4] = bf_lo(h.z) + g1.x * (a45[0] + b45[0]); v[rr][8 * j + 5] = bf_hi(h.z) + g1.y * (a45[1] + b45[1]);
                    v[rr][8 * j + 6] = bf_lo(h.w) + g1.z * (a67[0] + b67[0]); v[rr][8 * j + 7] = bf_hi(h.w) + g1.w * (a67[1] + b67[1]);
#pragma unroll
                    for (int i = 0; i < 8; ++i) ss[rr] += v[rr][8 * j + i] * v[rr][8 * j + i]; } }
            float rs[2];
#pragma unroll
            for (int rr = 0; rr < 2; ++rr) { rs[rr] = 1.0f / __builtin_sqrtf(wave_sum(ss[rr]) * (1.0f / DM) + EPS); if (tmo) rs[rr] = __builtin_nanf(""); }
#pragma unroll
            for (int j = 0; j < 2; ++j) { const int c = 8 * lane + 512 * j;
                const f32x4 g0 = *(const f32x4*)(gfin + c), g1 = *(const f32x4*)(gfin + c + 4);
#pragma unroll
                for (int rr = 0; rr < 2; ++rr) { float* orow = args.out + (size_t)(m + rr) * DM + c;
                    f32x4 o0, o1; o0.x = v[rr][8 * j + 0] * rs[rr] * g0.x; o0.y = v[rr][8 * j + 1] * rs[rr] * g0.y; o0.z = v[rr][8 * j + 2] * rs[rr] * g0.z; o0.w = v[rr][8 * j + 3] * rs[rr] * g0.w;
                    o1.x = v[rr][8 * j + 4] * rs[rr] * g1.x; o1.y = v[rr][8 * j + 5] * rs[rr] * g1.y; o1.z = v[rr][8 * j + 6] * rs[rr] * g1.z; o1.w = v[rr][8 * j + 7] * rs[rr] * g1.w;
                    *(f32x4*)orow = o0; *(f32x4*)(orow + 4) = o1; } }
        }
    }
#undef IN
#undef SEAM
}

extern "C" void kernel_launch(void* const* d_in, const int* in_sizes, int n_in, void* d_out, int out_size, void* d_ws, size_t ws_size, hipStream_t stream) {
    static int grid = 0;
    if (grid == 0) {
        if (n_in != 21 || in_sizes[0] != NTOK * DM || out_size != NTOK * DM || ws_size < WS_END) { fprintf(stderr, "kernel_launch: unexpected shapes (n_in %d, in0 %d, out %d, ws %zu)\n", n_in, n_in > 0 ? in_sizes[0] : -1, out_size, ws_size); grid = -1; return; }
        int dev = 0, cus = 0;
        if (hipGetDevice(&dev) != hipSuccess || hipDeviceGetAttribute(&cus, hipDeviceAttributeMultiprocessorCount, dev) != hipSuccess) { grid = -1; return; }
        if (hipFuncSetAttribute((const void*)fwd_kernel, hipFuncAttributeMaxDynamicSharedMemorySize, LDS_BYTES) != hipSuccess) { fprintf(stderr, "kernel_launch: hipFuncSetAttribute failed\n"); grid = -1; return; }
        int per_cu = 0;
        if (hipOccupancyMaxActiveBlocksPerMultiprocessor(&per_cu, (const void*)fwd_kernel, NWAVES * 64, LDS_BYTES) != hipSuccess || per_cu < 1) fprintf(stderr, "kernel_launch: occupancy query says %d\n", per_cu);
        (void)hipGetLastError();
        if (cus != 256) { fprintf(stderr, "kernel_launch: built for 256 CUs, found %d\n", cus); grid = -1; return; }
        grid = cus;
    }
    if (grid < 0) return;
    if (hipMemsetAsync((char*)d_ws + WS_CTL, 0, CTL_ZERO_BYTES, stream) != hipSuccess) return;
    Args a{};
    for (int i = 0; i < 21; ++i) a.in[i] = (const float*)d_in[i];
    a.out = (float*)d_out; a.ws = (unsigned char*)d_ws; a.pad = 0;
    constexpr int NPH = 10;
#if MK_N_LAUNCHES == 1
    a.ph_lo = 0; a.ph_hi = NPH; a.li = 0;
    hipLaunchKernelGGL(fwd_kernel, dim3(grid), dim3(NWAVES * 64), LDS_BYTES, stream, a);
#else
    for (int li = 0; li < NPH; ++li) { a.ph_lo = li; a.ph_hi = li + 1; a.li = 0;
        hipLaunchKernelGGL(fwd_kernel, dim3(grid), dim3(NWAVES * 64), LDS_BYTES, stream, a); }
#endif
}
```

```cpp
#include <hip/hip_runtime.h>
#include <cstdio>
#include <cstdint>

#ifndef MK_N_LAUNCHES
#define MK_N_LAUNCHES 1
#endif

#define GAS __attribute__((address_space(1)))
#define LAS __attribute__((address_space(3)))
typedef unsigned short bf16_t;
typedef short bf16x8 __attribute__((ext_vector_type(8)));
typedef short s16x4 __attribute__((ext_vector_type(4)));
typedef float f32x2 __attribute__((ext_vector_type(2)));
typedef float f32x4 __attribute__((ext_vector_type(4)));
typedef float f32x16 __attribute__((ext_vector_type(16)));
typedef unsigned u32x2 __attribute__((ext_vector_type(2)));
typedef unsigned u32x4 __attribute__((ext_vector_type(4)));
typedef __bf16 bf16x2_t __attribute__((ext_vector_type(2)));
typedef GAS unsigned gu32;

constexpr int NB = 8, SEQ = 8192, DM = 1024, NTOK = NB * SEQ;
constexpr int LDP = 4608;
constexpr int C_Q = 0, C_K = 512, C_V = 1024, C_U = 1536, C_SV = 2048, C_GA = 2560, C_GB = 3584;
constexpr size_t PO_Q = 0, PO_K = (size_t)32 << 20, PO_V = (size_t)64 << 20, PO_U = (size_t)96 << 20, PO_SV = (size_t)128 << 20, PO_GA = (size_t)160 << 20, PO_GB = (size_t)224 << 20;
constexpr int NEXP = 32, DEXP = 512;
constexpr float EPS = 1e-6f;
constexpr float LOG2E = 1.4426950408889634f;
constexpr float QS_N = 127.0f / 8.0f;
constexpr float QS_WIN = 127.0f * 32.0f / 4.5f;
constexpr float DQ_PROJ = 1.0f / (QS_N * QS_WIN);
constexpr float QS_YA = 127.0f / 4.0f;
constexpr float QS_YB = 127.0f / 8.0f;
constexpr float QS_WAB = 127.0f * 22.627417f / 4.5f;
constexpr float QS_MERGED = 127.0f / 4.0f;
constexpr float QS_WOUT = 127.0f * 32.0f / 4.5f;

constexpr size_t MiB = 1u << 20;
constexpr size_t WS_CTL = 0, CTL_ZERO_BYTES = 1 * MiB;
constexpr size_t WS_MOD = 1 * MiB;
constexpr size_t WS_WSP = 2 * MiB;
constexpr size_t WS_WR = 2 * MiB + 512 * 1024;
constexpr size_t WS_STATS = 3 * MiB;
constexpr size_t WS_LIST = 8 * MiB;
constexpr size_t WS_WIN = 24 * MiB;
constexpr size_t WS_WA = 33 * MiB, WS_WB = 34 * MiB;
constexpr size_t WS_WO = 35 * MiB;
constexpr size_t WS_BT1 = 40 * MiB;
constexpr size_t WS_BT2 = 104 * MiB;
constexpr size_t WS_WIN8 = 120 * MiB;
constexpr size_t WS_XN = 136 * MiB;
constexpr size_t WS_YA = 264 * MiB, WS_YB = 328 * MiB;
constexpr size_t WS_P = 392 * MiB;
constexpr size_t WS_HID = WS_P;
constexpr size_t WS_YBUF = WS_P + 136 * MiB;
constexpr size_t WS_END = WS_P + 576 * MiB;

constexpr int CW_TMO = 0, CW_CODE = 1;
constexpr int CW_BAR = 4096;
constexpr int CW_CNT = 65536;

constexpr int LDS_BYTES = 163840;
constexpr int RING_BYTES = 131072;
constexpr int GTAB_OFF = 131072;
constexpr int UTAB_OFF = GTAB_OFF + 9 * 1024;
constexpr int MOEB_OFF = UTAB_OFF + 128;
constexpr int ETAB_OFF = MOEB_OFF + 512;
constexpr int MISC_OFF = LDS_BYTES - 256;
constexpr int NWAVES = 8;

__device__ __forceinline__ unsigned cvtpk(float lo, float hi) { f32x2 v = {lo, hi}; bf16x2_t b = __builtin_convertvector(v, bf16x2_t); return __builtin_bit_cast(unsigned, b); }
__device__ __forceinline__ float bf_lo(unsigned u) { return __uint_as_float(u << 16); }
__device__ __forceinline__ float bf_hi(unsigned u) { return __uint_as_float(u & 0xffff0000u); }
__device__ __forceinline__ float wave_sum(float v) {
#pragma unroll
    for (int o = 1; o < 64; o <<= 1) v += __shfl_xor(v, o);
    return v;
}
__device__ __forceinline__ float fast_exp2(float x) { return __builtin_amdgcn_exp2f(x); }
__device__ __forceinline__ float fast_log2(float x) { return __builtin_amdgcn_logf(x); }
__device__ __forceinline__ float fast_rcp(float x) { return __builtin_amdgcn_rcpf(x); }
__device__ __forceinline__ float sigmoidf_(float x) { return fast_rcp(1.0f + fast_exp2(-x * LOG2E)); }
__device__ __forceinline__ float siluf_(float x) { return x * sigmoidf_(x); }
__device__ __forceinline__ float gelu_tanh_(float x) {
    const float u = x * (1.0f + 0.044715f * x * x);
    return x * fast_rcp(1.0f + fast_exp2(-2.0f * 0.7978845608028654f * LOG2E * u));
}
__device__ __forceinline__ unsigned pk4_fp8(float a, float b, float c, float d) {
    int p = __builtin_amdgcn_cvt_pk_fp8_f32(a, b, 0, false); p = __builtin_amdgcn_cvt_pk_fp8_f32(c, d, p, true); return (unsigned)p; }
constexpr float I8MAGIC = 12582912.0f;
__device__ __forceinline__ unsigned pack_b0(unsigned a, unsigned b, unsigned c, unsigned d) {
    return __builtin_amdgcn_perm(__builtin_amdgcn_perm(d, c, 0x0c0c0400u), __builtin_amdgcn_perm(b, a, 0x0c0c0400u), 0x05040100u); }
__device__ __forceinline__ unsigned pk4_i8m(float a, float b, float c, float d) {
    return pack_b0(__float_as_uint(__builtin_amdgcn_fmed3f(a, I8MAGIC - 127.0f, I8MAGIC + 127.0f)), __float_as_uint(__builtin_amdgcn_fmed3f(b, I8MAGIC - 127.0f, I8MAGIC + 127.0f)),
                   __float_as_uint(__builtin_amdgcn_fmed3f(c, I8MAGIC - 127.0f, I8MAGIC + 127.0f)), __float_as_uint(__builtin_amdgcn_fmed3f(d, I8MAGIC - 127.0f, I8MAGIC + 127.0f))); }
__device__ __forceinline__ unsigned pk4_i8(float a, float b, float c, float d) {
    const f32x2 lo = (f32x2){__builtin_amdgcn_fmed3f(a, -127.0f, 127.0f), __builtin_amdgcn_fmed3f(b, -127.0f, 127.0f)} + I8MAGIC, hi = (f32x2){__builtin_amdgcn_fmed3f(c, -127.0f, 127.0f), __builtin_amdgcn_fmed3f(d, -127.0f, 127.0f)} + I8MAGIC;
    return pack_b0(__float_as_uint(lo.x), __float_as_uint(lo.y), __float_as_uint(hi.x), __float_as_uint(hi.y)); }
#define LDS_WAIT() asm volatile("s_waitcnt lgkmcnt(0)" ::: "memory")
#define VM_WAIT() asm volatile("s_waitcnt vmcnt(0)" ::: "memory")

namespace pg8 {
constexpr int BM = 256, BK = 64, HALF = 128, HTB = HALF * BK * 2, STAGE_BYTES = 8 * HTB, NXCD = 8, WGM = 8;
__host__ __device__ __forceinline__ int lds_byte(int r, int c) { const int st = (r >> 4) * 2 + (c >> 5), rr = r & 15, cc = c & 31, ob = rr * 64 + cc * 2; return st * 1024 + (ob ^ (((ob >> 9) & 1) << 5)); }
__host__ __device__ __forceinline__ void stage_rc(int b, int& R, int& C) { const int st = b / 1024, sb = b % 1024, swz = sb ^ (((sb >> 9) & 1) << 5); R = (st >> 1) * 16 + swz / 64; C = (st & 1) * 32 + (swz % 64) / 2; }
__host__ __device__ __forceinline__ int perm32(int rho) { const int n = rho >> 4, i = rho & 15; return 8 * (i >> 2) + 4 * n + (i & 3); }

struct Unit { int pm, pn; };
struct Gemm { const bf16_t* A; const bf16_t* Bt; int lda, ldb, K; };

struct StaticOrder {
    int nM, nN, nwg, G, c;
    __host__ __device__ void init(int M, int N, int G_, int c_) { nM = M / BM; nN = N / BM; nwg = nM * nN; G = G_; c = c_; }
    __host__ __device__ bool next(int i, Unit& u) const {
        const long L = (long)i * G + c; if (L >= nwg) return false;
        int wgid = (int)L; { const int q = nwg / NXCD, r = nwg % NXCD, xcd = wgid % NXCD, off = wgid / NXCD; wgid = (xcd < r ? xcd * (q + 1) : r * (q + 1) + (xcd - r) * q) + off; }
        const int nig = WGM * nN, gid = wgid / nig, fm = gid * WGM, gsz = (nM - fm) < WGM ? (nM - fm) : WGM;
        u.pm = fm + ((wgid % nig) % gsz); u.pn = (wgid % nig) / gsz; return true;
    }
};
struct TableOrder {
    const LAS int* tab; int n;
    __device__ __forceinline__ bool next(int i, Unit& u) const { if (i >= n) return false; u.pm = tab[2 * i]; u.pn = tab[2 * i + 1]; return true; }
};

typedef int i32x4_t __attribute__((ext_vector_type(4)));
typedef int i32x8_t __attribute__((ext_vector_type(8)));
__device__ __forceinline__ i32x8_t cat8(bf16x8 lo, bf16x8 hi) { const i32x4_t a = __builtin_bit_cast(i32x4_t, lo), b = __builtin_bit_cast(i32x4_t, hi); return __builtin_shufflevector(a, b, 0, 1, 2, 3, 4, 5, 6, 7); }
template <class Epi, class Sched, bool ALIGN_EPI, bool GATHER, bool MIDK = false, bool FP8 = false, bool I8 = false>
__device__ __forceinline__ void gemm_phase(LAS unsigned char* lds, const Gemm g, const Sched& S, const Epi& E, const LAS unsigned* gtab) {
    const int tid = threadIdx.x, wid = __builtin_amdgcn_readfirstlane(tid >> 6), lane = tid & 63, wr = wid >> 2, wc = wid & 3, fr = lane & 15, fq = lane >> 4;
    constexpr int ESZ = (FP8 || I8) ? 1 : 2;
    const int K = g.K, nt = K * ESZ / (BK * 2);
    unsigned voffA[2], voffB[2];
    unsigned vG[2][2];
#pragma unroll
    for (int i = 0; i < 2; ++i) { int R, C; stage_rc(tid * 16 + i * 8192, R, C); const int Rb = Epi::PERM ? ((R & ~31) + perm32(R & 31)) : R;
        voffA[i] = (unsigned)(R * g.lda * ESZ + C * 2); voffB[i] = (unsigned)(Rb * g.ldb * ESZ + C * 2); vG[0][i] = 0u; vG[1][i] = 0u; }
    const size_t kstep = (size_t)(BK * 2);
    const size_t hstepA = (size_t)HALF * g.lda * ESZ, hstepB = (size_t)HALF * g.ldb * ESZ;
    const size_t tstepA = 2 * hstepA, tstepB = 2 * hstepB;
    const unsigned ldsw = (unsigned)wid * 1024u;
    constexpr int DK = FP8 ? 16 : 1024;
    const int aoff = lds_byte(wr * 64 + fr, FP8 ? 16 * fq : fq * 8), boff = lds_byte(wc * 32 + fr, FP8 ? 16 * fq : fq * 8);
#define PG8_SA(b, h) (((b) * 2 + (h)) * HTB)
#define PG8_SB(b, h) ((4 + (b) * 2 + (h)) * HTB)
#define PG8_STAGE(bufoff, gbase, voff) do { _Pragma("unroll") for (int _i = 0; _i < 2; ++_i) \
        __builtin_amdgcn_global_load_lds((const unsigned*)((const char*)(gbase) + (voff)[_i]), (LAS unsigned*)(lds + (bufoff) + ldsw + _i * 8192), 16, 0, 0); } while (0)
#define PG8_STAGE_A(b, h, ptr) do { if constexpr (GATHER) { PG8_STAGE(PG8_SA(b, h), (ptr), vG[h]); } else { PG8_STAGE(PG8_SA(b, h), (ptr) + (h) * hstepA, voffA); } } while (0)
#define PG8_LOADG(ui_) do { _Pragma("unroll") for (int _i = 0; _i < 2; ++_i) { int R_, C_; stage_rc(tid * 16 + _i * 8192, R_, C_); \
        vG[0][_i] = gtab[(ui_) * 256 + R_] + (unsigned)(C_ * 2); vG[1][_i] = gtab[(ui_) * 256 + 128 + R_] + (unsigned)(C_ * 2); } } while (0)
#define PG8_LDA(dst, b, h) do { _Pragma("unroll") for (int m = 0; m < 4; ++m) _Pragma("unroll") for (int k = 0; k < 2; ++k) dst[m][k] = *(const LAS bf16x8*)(lds + PG8_SA(b, h) + aoff + m * 2048 + k * DK); } while (0)
#define PG8_LDB(dst, b, h) do { _Pragma("unroll") for (int n = 0; n < 2; ++n) _Pragma("unroll") for (int k = 0; k < 2; ++k) dst[n][k] = *(const LAS bf16x8*)(lds + PG8_SB(b, h) + boff + n * 2048 + k * DK); } while (0)
#define PG8_MMA(ai, bj, At, Bt) do { __builtin_amdgcn_s_setprio(1); _Pragma("unroll") for (int m = 0; m < 4; ++m) _Pragma("unroll") for (int n = 0; n < 2; ++n) { \
        if constexpr (FP8) { acc[ai][bj][m][n] = __builtin_amdgcn_mfma_scale_f32_16x16x128_f8f6f4(cat8(Bt[n][0], Bt[n][1]), cat8(At[m][0], At[m][1]), acc[ai][bj][m][n], 0, 0, 0, 0x7f7f7f7f, 0, 0x7f7f7f7f); } \
        else if constexpr (I8) { _Pragma("unroll") for (int k = 0; k < 2; ++k) acc[ai][bj][m][n] = __builtin_bit_cast(f32x4, __builtin_amdgcn_mfma_i32_16x16x64_i8(__builtin_bit_cast(i32x4_t, Bt[n][k]), __builtin_bit_cast(i32x4_t, At[m][k]), __builtin_bit_cast(i32x4_t, acc[ai][bj][m][n]), 0, 0, 0)); } \
        else { _Pragma("unroll") for (int k = 0; k < 2; ++k) acc[ai][bj][m][n] = __builtin_amdgcn_mfma_f32_16x16x32_bf16(Bt[n][k], At[m][k], acc[ai][bj][m][n], 0, 0, 0); } } \
        __builtin_amdgcn_s_setprio(0); } while (0)
#define PG8_WAIT_V(n) asm volatile("s_waitcnt vmcnt(" #n ")" ::: "memory")
#define PG8_WAIT_L(n) asm volatile("s_waitcnt lgkmcnt(" #n ")" ::: "memory")
#define PG8_BAR __builtin_amdgcn_s_barrier()
#define PG8_SCHED __builtin_amdgcn_sched_barrier(0)
    Unit cur, nxt; int ui = 0;
    if (!S.next(0, cur)) return;
    f32x4 acc[2][2][4][2];
#pragma unroll
    for (int a = 0; a < 2; ++a)
#pragma unroll
        for (int b = 0; b < 2; ++b)
#pragma unroll
            for (int m = 0; m < 4; ++m)
#pragma unroll
                for (int n = 0; n < 2; ++n) acc[a][b][m][n] = (f32x4){0.f, 0.f, 0.f, 0.f};
    bf16x8 At[4][2], B0[2][2], B1[2][2];
    const char* cA = (const char*)g.A + (GATHER ? (size_t)0 : (size_t)cur.pm * tstepA); const char* cB = (const char*)g.Bt + (size_t)cur.pn * tstepB;
    if constexpr (GATHER) { PG8_LOADG(0); }
    PG8_STAGE(PG8_SB(0, 0), cB, voffB); PG8_STAGE(PG8_SB(0, 1), cB + hstepB, voffB); PG8_STAGE_A(0, 0, cA); PG8_STAGE_A(0, 1, cA);
    if (wr == 1) PG8_BAR;
    PG8_WAIT_V(2); PG8_BAR;
    PG8_STAGE(PG8_SB(1, 0), cB + kstep, voffB); PG8_STAGE_A(1, 0, cA + kstep); PG8_STAGE(PG8_SB(1, 1), cB + hstepB + kstep, voffB);
    PG8_WAIT_V(6); PG8_BAR;
    for (;;) {
        const bool has_next = S.next(ui + 1, nxt);
        const char* nA = has_next ? (const char*)g.A + (GATHER ? (size_t)0 : (size_t)nxt.pm * tstepA) : cA; const char* nB = has_next ? (const char*)g.Bt + (size_t)nxt.pn * tstepB : cB;
#pragma nounroll
        for (int t = 0; t < nt; t += 2) {
            const bool last = (t == nt - 2);
            const char* a1 = cA + (size_t)(t + 1) * kstep;
            const char* a2 = last ? nA : cA + (size_t)(t + 2) * kstep; const char* b2 = last ? nB : cB + (size_t)(t + 2) * kstep;
            const char* a3 = a2 + kstep; const char* b3 = b2 + kstep;
            if constexpr (MIDK) { if (t == (nt >> 1)) E.mid(acc, cur, wr, wc, fr, fq); }
            PG8_LDB(B0, 0, 0); PG8_LDB(B1, 0, 1); PG8_SCHED; PG8_LDA(At, 0, 0); PG8_STAGE_A(1, 1, a1);
            if constexpr (GATHER) { if (last && has_next) { PG8_LOADG(ui + 1); } }
            PG8_WAIT_V(8); PG8_WAIT_L(0); PG8_BAR; PG8_MMA(0, 0, At, B0); PG8_MMA(0, 1, At, B1); PG8_BAR; PG8_SCHED;
            PG8_LDA(At, 0, 1); PG8_STAGE(PG8_SB(0, 0), b2, voffB); PG8_STAGE(PG8_SB(0, 1), b2 + hstepB, voffB); PG8_STAGE_A(0, 0, a2);
            PG8_WAIT_V(8); PG8_WAIT_L(0); PG8_BAR; PG8_MMA(1, 0, At, B0); PG8_MMA(1, 1, At, B1); PG8_BAR; PG8_SCHED;
            PG8_LDB(B0, 1, 0); PG8_LDB(B1, 1, 1); PG8_SCHED; PG8_LDA(At, 1, 0); PG8_STAGE_A(0, 1, a2);
            PG8_WAIT_V(8); PG8_WAIT_L(0); PG8_BAR; PG8_MMA(0, 0, At, B0); PG8_MMA(0, 1, At, B1); PG8_BAR; PG8_SCHED;
            PG8_LDA(At, 1, 1); PG8_STAGE(PG8_SB(1, 0), b3, voffB); PG8_STAGE(PG8_SB(1, 1), b3 + hstepB, voffB); PG8_STAGE_A(1, 0, a3);
            PG8_WAIT_V(8); PG8_WAIT_L(0); PG8_BAR; PG8_MMA(1, 0, At, B0); PG8_MMA(1, 1, At, B1); PG8_BAR; PG8_SCHED;
        }
        if constexpr (ALIGN_EPI) { if (wr == 0) PG8_BAR; }
        E(acc, cur, ui, wr, wc, fr, fq);
        if (!has_next) break;
#pragma unroll
        for (int a = 0; a < 2; ++a)
#pragma unroll
            for (int b = 0; b < 2; ++b)
#pragma unroll
                for (int m = 0; m < 4; ++m)
#pragma unroll
                    for (int n = 0; n < 2; ++n) acc[a][b][m][n] = (f32x4){0.f, 0.f, 0.f, 0.f};
        cur = nxt; cA = nA; cB = nB; ++ui;
        if constexpr (ALIGN_EPI) { if (wr == 1) PG8_BAR; }
    }
    PG8_WAIT_V(0);
    if constexpr (!ALIGN_EPI) { if (wr == 0) PG8_BAR; }
    PG8_BAR;
#undef PG8_SA
#undef PG8_SB
#undef PG8_STAGE
#undef PG8_STAGE_A
#undef PG8_LOADG
#undef PG8_LDA
#undef PG8_LDB
#undef PG8_MMA
#undef PG8_WAIT_V
#undef PG8_WAIT_L
#undef PG8_BAR
#undef PG8_SCHED
}

typedef f32x4 AccT[2][2][4][2];

struct EpiProj {
    static constexpr bool PERM = true;
    bf16_t* O; f32x2* svst;
    template <int MODE, bool STATS, int LAYOUT> __device__ __forceinline__ void run(const AccT& acc, const Unit& u, int wr, int wc, int fr, int fq) const {
        const int row0 = u.pm * BM + wr * 64 + fr, colt = wc * 32 + 8 * fq;
        const int pn = u.pn; bf16_t* base; size_t pitch = 0; int c0 = 0; size_t bjstep = HALF;
        if (pn < 6) { const int b = (u.pm * BM) / SEQ, hd = 4 * (pn & 1) + (colt >> 6);
            base = O + (size_t)(pn >> 1) * PO_K + ((size_t)(b * 8 + hd) * SEQ - (size_t)b * SEQ) * 64; pitch = 64; c0 = colt & 63; bjstep = (size_t)2 * SEQ * 64; }
        else if (pn < 8) { base = O + PO_U; c0 = (pn & 1) * 32 + (colt >> 3); bjstep = 16 * 256; }
        else if (pn < 10) { base = O + PO_SV; pitch = 512; c0 = (pn & 1) * 256 + colt; }
        else { base = O + (pn < 14 ? PO_GA : PO_GB); pitch = 1024; c0 = ((pn - 10) & 3) * 256 + colt; }
#pragma unroll
        for (int ai = 0; ai < 2; ++ai)
#pragma unroll
            for (int m = 0; m < 4; ++m) { const int row = row0 + ai * HALF + m * 16; float s1 = 0.f, s2 = 0.f;
                bf16_t* rowp;
                if (LAYOUT == 0) rowp = base + (size_t)row * pitch + c0;
                else if (LAYOUT == 1) rowp = base + (size_t)(row & ~31) * 64 + (c0 >> 3) * 256 + (row & 31) * 8;
                else rowp = base + ((size_t)(row >> 5) * 64 + c0) * 256 + (row & 31) * 8;
#pragma unroll
                for (int bj = 0; bj < 2; ++bj) { f32x2 v[4];
#pragma unroll
                    for (int jp = 0; jp < 4; ++jp) { const i32x4_t ia = __builtin_bit_cast(i32x4_t, acc[ai][bj][m][jp >> 1]);
                        const f32x2 q = {(float)ia[2 * (jp & 1)], (float)ia[2 * (jp & 1) + 1]};
                        if (MODE == 0) v[jp] = q * DQ_PROJ;
                        if (MODE == 1) v[jp] = q * (DQ_PROJ * 0.125f * LOG2E);
                        if (MODE == 2) {
                            constexpr float KG = -2.0f * 0.7978845608028654f * LOG2E, K0 = KG * DQ_PROJ, K1 = KG * 0.044715f * DQ_PROJ * DQ_PROJ * DQ_PROJ, IDQ = 1.0f / DQ_PROJ;
                            const f32x2 z = q * ((q * q) * K1 + K0);
                            const f32x2 d = (f32x2){fast_exp2(z.x), fast_exp2(z.y)} * IDQ + IDQ;
                            v[jp] = q * (f32x2){fast_rcp(d.x), fast_rcp(d.y)}; }
                        if (STATS) { s1 += v[jp].x + v[jp].y; const f32x2 sq = v[jp] * v[jp]; s2 += sq.x + sq.y; } }
                    u32x4 w; w.x = cvtpk(v[0].x, v[0].y); w.y = cvtpk(v[1].x, v[1].y); w.z = cvtpk(v[2].x, v[2].y); w.w = cvtpk(v[3].x, v[3].y);
                    *(u32x4*)(rowp + bj * bjstep) = w; }
                if (STATS) { s1 += __shfl_xor(s1, 16); s1 += __shfl_xor(s1, 32); s2 += __shfl_xor(s2, 16); s2 += __shfl_xor(s2, 32);
                    if (fq == 0) svst[(size_t)row * 8 + (u.pn - 8) * 4 + wc] = (f32x2){s1, s2}; } }
    }
    __device__ __forceinline__ void run_gates(const AccT& acc, const Unit& u, int wr, int wc, int fr, int fq) const {
        const int row0 = u.pm * BM + wr * 64 + fr, col0 = (u.pn - 10) * HALF + wc * 32 + 8 * fq;
#pragma unroll
        for (int ai = 0; ai < 2; ++ai)
#pragma unroll
            for (int m = 0; m < 4; ++m) { f32x2 rv[4], sv[4];
#pragma unroll
                for (int jp = 0; jp < 4; ++jp) { const i32x4_t ia = __builtin_bit_cast(i32x4_t, acc[ai][0][m][jp >> 1]), ib = __builtin_bit_cast(i32x4_t, acc[ai][1][m][jp >> 1]);
                    const f32x2 za = __builtin_elementwise_min((f32x2){(float)ia[2 * (jp & 1)], (float)ia[2 * (jp & 1) + 1]} * (-LOG2E * DQ_PROJ), (f32x2){60.0f, 60.0f});
                    const f32x2 zb = __builtin_elementwise_min((f32x2){(float)ib[2 * (jp & 1)], (float)ib[2 * (jp & 1) + 1]} * (-LOG2E * DQ_PROJ), (f32x2){60.0f, 60.0f});
                    const f32x2 pa = (f32x2){fast_exp2(za.x), fast_exp2(za.y)} + 1.0f, pb = (f32x2){fast_exp2(zb.x), fast_exp2(zb.y)} + 1.0f;
                    const f32x2 pr = pa * pb; const f32x2 t = {fast_rcp(pr.x), fast_rcp(pr.y)};
                    sv[jp] = pa * t; rv[jp] = pb * (pb * t); }
                u32x4 wr_; wr_.x = cvtpk(rv[0].x, rv[0].y); wr_.y = cvtpk(rv[1].x, rv[1].y); wr_.z = cvtpk(rv[2].x, rv[2].y); wr_.w = cvtpk(rv[3].x, rv[3].y);
#pragma unroll
                for (int jp = 0; jp < 4; ++jp) sv[jp] = sv[jp] * 255.0f + 8388608.0f;
                u32x2 wb; wb.x = pack_b0(__float_as_uint(sv[0].x), __float_as_uint(sv[0].y), __float_as_uint(sv[1].x), __float_as_uint(sv[1].y)); wb.y = pack_b0(__float_as_uint(sv[2].x), __float_as_uint(sv[2].y), __float_as_uint(sv[3].x), __float_as_uint(sv[3].y));
                const size_t off = (size_t)(row0 + ai * HALF + m * 16) * DM + col0;
                *(u32x4*)(O + PO_GA + off) = wr_; *(u32x2*)((unsigned char*)(O + PO_GB) + off) = wb; }
    }
    __device__ __forceinline__ void operator()(const AccT& acc, const Unit& u, int, int wr, int wc, int fr, int fq) const {
        const int pn = u.pn;
        if (pn < 2) run<1, false, 1>(acc, u, wr, wc, fr, fq); else if (pn < 4) run<0, false, 1>(acc, u, wr, wc, fr, fq); else if (pn < 6) run<0, false, 0>(acc, u, wr, wc, fr, fq);
        else if (pn < 8) run<2, false, 2>(acc, u, wr, wc, fr, fq); else if (pn < 10) run<2, true, 0>(acc, u, wr, wc, fr, fq); else run_gates(acc, u, wr, wc, fr, fq);
    }
};

struct EpiGates {
    static constexpr bool PERM = true;
    bf16_t* O;
    __device__ __forceinline__ void operator()(const AccT& acc, const Unit& u, int, int wr, int wc, int fr, int fq) const {
        const int row0 = u.pm * BM + wr * 64 + fr, col0 = u.pn * HALF + wc * 32 + 8 * fq;
#pragma unroll
        for (int ai = 0; ai < 2; ++ai)
#pragma unroll
            for (int m = 0; m < 4; ++m) { float rv[8], sv[8];
#pragma unroll
                for (int j = 0; j < 8; ++j) { const float a = acc[ai][0][m][j >> 2][j & 3], b = acc[ai][1][m][j >> 2][j & 3];
                    const float eb = fast_exp2(b * (-LOG2E / 32.0f)), ea = fast_exp2(a * (-LOG2E / 32.0f));
                    sv[j] = fast_rcp(1.0f + eb); rv[j] = (1.0f + eb) * fast_rcp(1.0f + ea); }
                u32x4 wr_; wr_.x = cvtpk(rv[0], rv[1]); wr_.y = cvtpk(rv[2], rv[3]); wr_.z = cvtpk(rv[4], rv[5]); wr_.w = cvtpk(rv[6], rv[7]);
                unsigned q8[8];
#pragma unroll
                for (int j = 0; j < 8; ++j) q8[j] = (unsigned)(sv[j] * 255.0f + 0.5f);
                u32x2 wb; wb.x = q8[0] | (q8[1] << 8) | (q8[2] << 16) | (q8[3] << 24); wb.y = q8[4] | (q8[5] << 8) | (q8[6] << 16) | (q8[7] << 24);
                const size_t off = (size_t)(row0 + ai * HALF + m * 16) * DM + col0;
                *(u32x4*)(O + PO_GA + off) = wr_; *(u32x2*)((unsigned char*)(O + PO_GB) + off) = wb; }
    }
};

struct EpiMerge {
    static constexpr bool PERM = true;
    unsigned char* O; const bf16_t* Pg;
    __device__ __forceinline__ void mid(AccT& acc, const Unit& u, int wr, int wc, int fr, int fq) const {
        int row0 = u.pm * BM + wr * 64 + fr, col0 = u.pn * BM + wc * 32 + 8 * fq;
        asm volatile("" : "+v"(row0), "+v"(col0));
        u32x4 rw[2][4][2];
#pragma unroll
        for (int ai = 0; ai < 2; ++ai)
#pragma unroll
            for (int m = 0; m < 4; ++m)
#pragma unroll
                for (int bj = 0; bj < 2; ++bj) rw[ai][m][bj] = *(const u32x4*)(Pg + PO_GA + (size_t)(row0 + ai * HALF + m * 16) * DM + col0 + bj * HALF);
#pragma unroll
        for (int ai = 0; ai < 2; ++ai)
#pragma unroll
            for (int m = 0; m < 4; ++m)
#pragma unroll
                for (int bj = 0; bj < 2; ++bj) { const u32x4 g = rw[ai][m][bj];
                    const f32x4 r0 = (f32x4){bf_lo(g.x), bf_hi(g.x), bf_lo(g.y), bf_hi(g.y)} * (QS_YB / QS_YA), r1 = (f32x4){bf_lo(g.z), bf_hi(g.z), bf_lo(g.w), bf_hi(g.w)} * (QS_YB / QS_YA);
                    f32x4 t0 = __builtin_convertvector(__builtin_bit_cast(i32x4_t, acc[ai][bj][m][0]), f32x4) * r0, t1 = __builtin_convertvector(__builtin_bit_cast(i32x4_t, acc[ai][bj][m][1]), f32x4) * r1;
                    i32x4_t q0, q1;
#pragma unroll
                    for (int j = 0; j < 4; ++j) { q0[j] = (int)__builtin_amdgcn_fmed3f(t0[j], -2.0e9f, 2.0e9f); q1[j] = (int)__builtin_amdgcn_fmed3f(t1[j], -2.0e9f, 2.0e9f); }
                    acc[ai][bj][m][0] = __builtin_bit_cast(f32x4, q0); acc[ai][bj][m][1] = __builtin_bit_cast(f32x4, q1); }
    }
    __device__ __forceinline__ void operator()(const AccT& acc, const Unit& u, int, int wr, int wc, int fr, int fq) const {
        const int row0 = u.pm * BM + wr * 64 + fr, col0 = u.pn * BM + wc * 32 + 8 * fq;
        u32x2 gw[2][4][2];
#pragma unroll
        for (int ai = 0; ai < 2; ++ai)
#pragma unroll
            for (int m = 0; m < 4; ++m)
#pragma unroll
                for (int bj = 0; bj < 2; ++bj) gw[ai][m][bj] = *(const u32x2*)((const unsigned char*)(Pg + PO_GB) + (size_t)(row0 + ai * HALF + m * 16) * DM + col0 + bj * HALF);
#pragma unroll
        for (int ai = 0; ai < 2; ++ai)
#pragma unroll
            for (int m = 0; m < 4; ++m) { const size_t row = (size_t)(row0 + ai * HALF + m * 16);
#pragma unroll
                for (int bj = 0; bj < 2; ++bj) { const u32x2 g4 = gw[ai][m][bj];
                    float v[8];
#pragma unroll
                    for (int j = 0; j < 4; ++j) { v[j] = (float)__builtin_bit_cast(i32x4_t, acc[ai][bj][m][0])[j] * ((float)((g4.x >> (8 * j)) & 255u) * (QS_MERGED / (255.0f * QS_YB * QS_WAB))) + I8MAGIC; v[4 + j] = (float)__builtin_bit_cast(i32x4_t, acc[ai][bj][m][1])[j] * ((float)((g4.y >> (8 * j)) & 255u) * (QS_MERGED / (255.0f * QS_YB * QS_WAB))) + I8MAGIC; }
                    u32x2 w; w.x = pk4_i8m(v[0], v[1], v[2], v[3]); w.y = pk4_i8m(v[4], v[5], v[6], v[7]);
                    *(u32x2*)(O + row * DM + col0 + bj * HALF) = w; } }
    }
};

struct EpiResid {
    static constexpr bool PERM = true;
    const float* X; bf16_t* H; const float* mod; float* stats;
    __device__ __forceinline__ void operator()(const AccT& acc, const Unit& u, int, int wr, int wc, int fr, int fq) const {
        const int rowt = u.pm * BM + wr * 64 + fr, col0 = u.pn * BM + wc * 32 + 8 * fq;
        const int b = (u.pm * BM) / SEQ;
        const float* gt = mod + (size_t)b * 6144 + 2 * DM;
        f32x4 g4[2][2];
#pragma unroll
        for (int bj = 0; bj < 2; ++bj)
#pragma unroll
            for (int n = 0; n < 2; ++n) g4[bj][n] = *(const f32x4*)(gt + col0 + bj * HALF + n * 4) * (1.0f / (QS_MERGED * QS_WOUT));
        f32x4 xv[4][2][2]; u32x4 wv[4][2]; float sq[4];
#pragma unroll
        for (int ai = 0; ai < 2; ++ai) {
#pragma unroll
            for (int m = 0; m < 4; ++m)
#pragma unroll
                for (int bj = 0; bj < 2; ++bj) { const size_t off = (size_t)(rowt + ai * HALF + m * 16) * DM + col0 + bj * HALF;
                    xv[m][bj][0] = *(const f32x4*)(X + off); xv[m][bj][1] = *(const f32x4*)(X + off + 4); }
            if (ai == 1) {
#pragma unroll
                for (int m = 0; m < 4; ++m) { const size_t row = (size_t)(rowt + m * 16);
#pragma unroll
                    for (int bj = 0; bj < 2; ++bj) *(u32x4*)(H + row * DM + col0 + bj * HALF) = wv[m][bj];
                    if (fq == 0) stats[row * 16 + u.pn * 4 + wc] = sq[m]; }
            }
#pragma unroll
            for (int m = 0; m < 4; ++m) { float ss = 0.f;
#pragma unroll
                for (int bj = 0; bj < 2; ++bj) {
                    const f32x4 h0 = xv[m][bj][0] + g4[bj][0] * __builtin_convertvector(__builtin_bit_cast(i32x4_t, acc[ai][bj][m][0]), f32x4), h1 = xv[m][bj][1] + g4[bj][1] * __builtin_convertvector(__builtin_bit_cast(i32x4_t, acc[ai][bj][m][1]), f32x4);
                    ss += (h0[0] * h0[0] + h0[1] * h0[1]) + (h0[2] * h0[2] + h0[3] * h0[3]) + (h1[0] * h1[0] + h1[1] * h1[1]) + (h1[2] * h1[2] + h1[3] * h1[3]);
                    wv[m][bj].x = cvtpk(h0[0], h0[1]); wv[m][bj].y = cvtpk(h0[2], h0[3]); wv[m][bj].z = cvtpk(h1[0], h1[1]); wv[m][bj].w = cvtpk(h1[2], h1[3]); }
                ss += __shfl_xor(ss, 16); ss += __shfl_xor(ss, 32); sq[m] = ss; }
            if (ai == 0) asm volatile("" : "+v"(wv[0][0]), "+v"(wv[0][1]), "+v"(wv[1][0]), "+v"(wv[1][1]), "+v"(wv[2][0]), "+v"(wv[2][1]), "+v"(wv[3][0]), "+v"(wv[3][1]));
        }
#pragma unroll
        for (int m = 0; m < 4; ++m) { const size_t row = (size_t)(rowt + HALF + m * 16);
#pragma unroll
            for (int bj = 0; bj < 2; ++bj) *(u32x4*)(H + row * DM + col0 + bj * HALF) = wv[m][bj];
            if (fq == 0) stats[row * 16 + u.pn * 4 + wc] = sq[m]; }
    }
};

struct EpiSwiglu {
    static constexpr bool PERM = true;
    unsigned char* Hid;
    __device__ __forceinline__ void operator()(const AccT& acc, const Unit& u, int, int wr, int wc, int fr, int fq) const {
        const int row0 = u.pm * BM + wr * 64 + fr, col0 = (u.pn & 3) * HALF + wc * 32 + 8 * fq;
#pragma unroll
        for (int ai = 0; ai < 2; ++ai)
#pragma unroll
            for (int m = 0; m < 4; ++m) { float v[8];
#pragma unroll
                for (int j = 0; j < 4; ++j) {
                    v[j] = (acc[ai][0][m][0][j] * acc[ai][1][m][0][j]) * fast_rcp(fast_exp2(acc[ai][0][m][0][j] * (-LOG2E * 0.03125f)) * 1024.0f + 1024.0f);
                    v[4 + j] = (acc[ai][0][m][1][j] * acc[ai][1][m][1][j]) * fast_rcp(fast_exp2(acc[ai][0][m][1][j] * (-LOG2E * 0.03125f)) * 1024.0f + 1024.0f); }
                u32x2 w; w.x = pk4_fp8(v[0], v[1], v[2], v[3]); w.y = pk4_fp8(v[4], v[5], v[6], v[7]);
                *(u32x2*)(Hid + (size_t)(row0 + ai * HALF + m * 16) * DEXP + col0) = w; }
    }
};

struct EpiScatter {
    static constexpr bool PERM = true;
    unsigned char* Y; const LAS u32x2* etab;
    __device__ __forceinline__ void operator()(const AccT& acc, const Unit& u, int ui, int wr, int wc, int fr, int fq) const {
        const int col0 = (u.pn & 3) * BM + wc * 32 + 8 * fq;
#pragma unroll
        for (int ai = 0; ai < 2; ++ai)
#pragma unroll
            for (int m = 0; m < 4; ++m) { const u32x2 en = etab[ui * 256 + ai * HALF + wr * 64 + m * 16 + fr];
                if (en.x != 0xffffffffu) { const float wt = __uint_as_float(en.y) * 0.5f;
                    unsigned char* rowp = Y + (size_t)en.x * DM + col0;
#pragma unroll
                    for (int bj = 0; bj < 2; ++bj) { const f32x4 a0 = acc[ai][bj][m][0] * wt, a1 = acc[ai][bj][m][1] * wt;
                        u32x2 w; w.x = pk4_fp8(a0[0], a0[1], a0[2], a0[3]); w.y = pk4_fp8(a1[0], a1[1], a1[2], a1[3]); *(u32x2*)(rowp + bj * HALF) = w; } } }
    }
};
}

#define XB_TMO      128
#define XB_XCNT(j)  (256  + 64 * (j))
#define XB_XSUB(j)  (1280 + 64 * (j))
#define XB_XGEN(j)  (2304 + 64 * (j))
#define XB_TOP      3328
#define XB_TOPGEN   3392
#define XCD_BAR_WORDS 3456
#define XB_SPIN_CAP (1u << 18)
__device__ __forceinline__ unsigned xb_ld(unsigned* p)              { return __hip_atomic_load(p, __ATOMIC_RELAXED, __HIP_MEMORY_SCOPE_AGENT); }
__device__ __forceinline__ unsigned xb_add(unsigned* p, unsigned v) { return __hip_atomic_fetch_add(p, v, __ATOMIC_RELAXED, __HIP_MEMORY_SCOPE_AGENT); }
__device__ __forceinline__ unsigned xb_xcc_id() { return (unsigned)__builtin_amdgcn_s_getreg((3 << 11) | 20) & 0xFu; }
#define XB_SPIN(cond, bar) do { unsigned _sp = 0; while (cond) { __builtin_amdgcn_s_sleep(1); \
    if ((++_sp & 255u) == 0u) { if (xb_ld(&(bar)[XB_TMO])) break; if (_sp > XB_SPIN_CAP) { atomicAdd(&(bar)[XB_TMO], 1u); break; } } } } while (0)
struct XcdBarrier { unsigned* bar; unsigned x; volatile LAS unsigned* st; };
__device__ __forceinline__ XcdBarrier xcd_barrier_post(unsigned* bar, volatile LAS unsigned* st) {
    XcdBarrier b; b.bar = bar; b.x = xb_xcc_id(); b.st = st;
    if (threadIdx.x == 0) (void)xb_add(&bar[XB_XCNT(b.x)], 1u);
    return b;
}
__device__ __forceinline__ void xcd_barrier_complete(unsigned* bar, unsigned x, unsigned& nloc, unsigned& nx) {
    const unsigned G = gridDim.x * gridDim.y * gridDim.z;
    unsigned sum, cnt, mine, sp = 0u;
    for (;;) {
        sum = 0u; cnt = 0u; mine = 0u;
#pragma unroll
        for (unsigned j = 0; j < 16; ++j) { const unsigned c = xb_ld(&bar[XB_XCNT(j)]); sum += c; cnt += (c > 0u) ? 1u : 0u; mine = (j == x) ? c : mine; }
        if (sum == G) break;
        __builtin_amdgcn_s_sleep(1);
        if ((++sp & 255u) == 0u) { if (xb_ld(&bar[XB_TMO])) break; if (sp > XB_SPIN_CAP) { atomicAdd(&bar[XB_TMO], 1u); break; } }
    }
    nloc = mine > 0u ? mine : 1u; nx = cnt > 0u ? cnt : 1u;
}
__device__ __forceinline__ void xcd_barrier(const XcdBarrier& b) {
    asm volatile("s_waitcnt vmcnt(0)" ::: "memory");
    __syncthreads();
    if (threadIdx.x == 0) {
        unsigned* bar = b.bar;
        __builtin_amdgcn_s_waitcnt(0);
        unsigned nloc = b.st[0], nx = b.st[1];
        if (nloc == 0u) { xcd_barrier_complete(bar, b.x, nloc, nx); b.st[0] = nloc; b.st[1] = nx; }
        const unsigned old = xb_add(&bar[XB_XSUB(b.x)], 1u);
        const unsigned gen = old / nloc;
        if (old + 1u == (gen + 1u) * nloc) {
            __builtin_amdgcn_fence(__ATOMIC_RELEASE, "agent");
            asm volatile("s_waitcnt vmcnt(0)" ::: "memory");
            const unsigned og = xb_add(&bar[XB_TOP], 1u);
            const unsigned tg = og / nx;
            if (og + 1u == (tg + 1u) * nx) xb_add(&bar[XB_TOPGEN], 1u);
            else XB_SPIN(xb_ld(&bar[XB_TOPGEN]) == tg, bar);
            __builtin_amdgcn_fence(__ATOMIC_ACQUIRE, "agent");
            xb_add(&bar[XB_XGEN(b.x)], 1u);
            asm volatile("s_waitcnt vmcnt(0)" ::: "memory");
        } else {
            XB_SPIN(xb_ld(&bar[XB_XGEN(b.x)]) == gen, bar);
            __builtin_amdgcn_fence(__ATOMIC_ACQUIRE, "agent");
            asm volatile("s_waitcnt vmcnt(0)" ::: "memory");
        }
    }
    __syncthreads();
}

struct Args {
    const float* in[21];
    float* out; unsigned char* ws;
    int ph_lo, ph_hi, li, pad;
};
enum { I_X = 0, I_C, I_GMIX, I_GFFN, I_WADA, I_BADA, I_WIN, I_WSBA, I_GSGU, I_WSP, I_BSP, I_WSGU, I_WOUT, I_WRG, I_BRG, I_WRE, I_BRE, I_WEG, I_WEU, I_WED, I_GFIN };

__device__ __forceinline__ void transpose_tile(const float* src, int N, bf16_t* dst, int ldo, LAS float* scr, int lane) {
#pragma unroll 8
    for (int i = 0; i < 32; ++i) { const int kk = 2 * i + (lane >> 5); scr[kk * 33 + (lane & 31)] = src[(size_t)kk * N + (lane & 31)]; }
    LDS_WAIT(); asm volatile("" ::: "memory");
    const int c = lane & 7;
#pragma unroll
    for (int j = 0; j < 4; ++j) { const int n = (lane >> 3) + 8 * j; const LAS float* s = scr + (8 * c) * 33 + n;
        u32x4 o; o.x = cvtpk(s[0 * 33], s[1 * 33]); o.y = cvtpk(s[2 * 33], s[3 * 33]); o.z = cvtpk(s[4 * 33], s[5 * 33]); o.w = cvtpk(s[6 * 33], s[7 * 33]);
        *(u32x4*)(dst + (size_t)n * ldo + 8 * c) = o; }
    LDS_WAIT(); asm volatile("" ::: "memory");
}

__device__ __forceinline__ void transpose_tile8(const float* src, int N, unsigned char* dst, int ldo, LAS float* scr, int lane, float scale) {
#pragma unroll 8
    for (int i = 0; i < 32; ++i) { const int kk = 2 * i + (lane >> 5); scr[kk * 33 + (lane & 31)] = src[(size_t)kk * N + (lane & 31)]; }
    LDS_WAIT(); asm volatile("" ::: "memory");
    const int c = lane & 3;
#pragma unroll
    for (int j = 0; j < 2; ++j) { const int n = (lane >> 2) + 16 * j; const LAS float* s = scr + (16 * c) * 33 + n;
        u32x4 o;
        o.x = pk4_fp8(s[0 * 33] * scale, s[1 * 33] * scale, s[2 * 33] * scale, s[3 * 33] * scale); o.y = pk4_fp8(s[4 * 33] * scale, s[5 * 33] * scale, s[6 * 33] * scale, s[7 * 33] * scale);
        o.z = pk4_fp8(s[8 * 33] * scale, s[9 * 33] * scale, s[10 * 33] * scale, s[11 * 33] * scale); o.w = pk4_fp8(s[12 * 33] * scale, s[13 * 33] * scale, s[14 * 33] * scale, s[15 * 33] * scale);
        *(u32x4*)(dst + (size_t)n * ldo + 16 * c) = o; }
    LDS_WAIT(); asm volatile("" ::: "memory");
}

__device__ __forceinline__ void transpose_tile_i8(const float* src, int N, unsigned char* dst, int ldo, LAS float* scr, int lane, float scale) {
#pragma unroll 8
    for (int i = 0; i < 32; ++i) { const int kk = 2 * i + (lane >> 5); scr[kk * 33 + (lane & 31)] = src[(size_t)kk * N + (lane & 31)]; }
    LDS_WAIT(); asm volatile("" ::: "memory");
    const int c = lane & 3;
#pragma unroll
    for (int j = 0; j < 2; ++j) { const int n = (lane >> 2) + 16 * j; const LAS float* s = scr + (16 * c) * 33 + n;
        u32x4 o;
        o.x = pk4_i8(s[0 * 33] * scale, s[1 * 33] * scale, s[2 * 33] * scale, s[3 * 33] * scale); o.y = pk4_i8(s[4 * 33] * scale, s[5 * 33] * scale, s[6 * 33] * scale, s[7 * 33] * scale);
        o.z = pk4_i8(s[8 * 33] * scale, s[9 * 33] * scale, s[10 * 33] * scale, s[11 * 33] * scale); o.w = pk4_i8(s[12 * 33] * scale, s[13 * 33] * scale, s[14 * 33] * scale, s[15 * 33] * scale);
        *(u32x4*)(dst + (size_t)n * ldo + 16 * c) = o; }
    LDS_WAIT(); asm volatile("" ::: "memory");
}

__device__ __forceinline__ int crow(int reg, int hh) { return (reg & 3) + 8 * (reg >> 2) + 4 * hh; }
__device__ __forceinline__ bf16x8 pack8(const f32x16& x, int s) {
    u32x4 p; p.x = cvtpk(x[8 * s + 0], x[8 * s + 1]); p.y = cvtpk(x[8 * s + 2], x[8 * s + 3]); p.z = cvtpk(x[8 * s + 4], x[8 * s + 5]); p.w = cvtpk(x[8 * s + 6], x[8 * s + 7]);
    return __builtin_bit_cast(bf16x8, p);
}
typedef short v4i16_t __attribute__((ext_vector_type(4)));
__device__ __forceinline__ s16x4 tr_read(const LAS unsigned char* p) { return __builtin_bit_cast(s16x4, __builtin_amdgcn_ds_read_tr16_b64_v4i16((LAS v4i16_t*)p)); }
__device__ __forceinline__ bf16x8 cat4(s16x4 lo, s16x4 hi) { return (bf16x8){lo[0], lo[1], lo[2], lo[3], hi[0], hi[1], hi[2], hi[3]}; }
#define MFMA32(a, b, c) __builtin_amdgcn_mfma_f32_32x32x16_bf16((a), (b), (c), 0, 0, 0)
constexpr int VROW = 144;

template <bool DIAG>
__device__ __forceinline__ bool attn_iter(bf16x8 (&kf)[4], u32x4 (&vr)[4], const bf16x8 (&qf)[4], const bf16x8 (&ut)[2], f32x16& negc, f32x16 (&ot)[2],
                                          const bf16_t* Kp, const bf16_t* Vp, int sb, LAS unsigned char* vw, const LAS unsigned char* trb, int r, int hh) {
#pragma unroll
    for (int c = 0; c < 4; ++c) *(LAS u32x4*)(vw + 8 * c * VROW) = vr[c];
    f32x16 zero;
#pragma unroll
    for (int i = 0; i < 16; ++i) zero[i] = 0.f;
    f32x16 s = MFMA32(kf[0], qf[0], zero);
#pragma unroll
    for (int kk = 1; kk < 4; ++kk) s = MFMA32(kf[kk], qf[kk], s);
    {
        const int sn = sb >= 64 ? sb - 64 : 0;
#pragma unroll
        for (int kk = 0; kk < 4; ++kk) kf[kk] = *(const bf16x8*)(Kp + (size_t)sn * 64 + 512 * kk);
#pragma unroll
        for (int c = 0; c < 4; ++c) vr[c] = *(const u32x4*)(Vp + (size_t)(sn + 8 * c) * 64);
    }
    f32x16 sp, xx;
#pragma unroll
    for (int i = 0; i < 16; ++i) {
        const float zc = __builtin_amdgcn_fmed3f(s[i], -120.0f, 120.0f);
        float spv = fast_log2(1.0f + fast_exp2(zc));
        float xv = zc - spv;
        if (DIAG && !(crow(i, hh) < r)) { spv = 0.f; xv = -INFINITY; }
        sp[i] = spv; xx[i] = xv;
    }
    const bf16x8 l0 = pack8(sp, 0), l1 = pack8(sp, 1);
    bf16x8 ones;
#pragma unroll
    for (int j = 0; j < 8; ++j) ones[j] = (short)0x3F80;
    f32x16 aft = MFMA32(ut[0], l0, negc); aft = MFMA32(ut[1], l1, aft);
    f32x16 cn = MFMA32(ones, l0, negc); cn = MFMA32(ones, l1, cn);
    f32x16 w;
#pragma unroll
    for (int i = 0; i < 16; ++i) w[i] = fast_exp2(xx[i] - aft[i]);
    const bf16x8 w0 = pack8(w, 0), w1 = pack8(w, 1);
#pragma unroll
    for (int d = 0; d < 2; ++d) {
        const bf16x8 v0 = cat4(tr_read(trb + 64 * d), tr_read(trb + 8 * VROW + 64 * d));
        const bf16x8 v1 = cat4(tr_read(trb + 16 * VROW + 64 * d), tr_read(trb + 24 * VROW + 64 * d));
        ot[d] = MFMA32(v0, w0, ot[d]); ot[d] = MFMA32(v1, w1, ot[d]);
    }
    negc = cn;
    return (sb == 0) || __all(cn[0] > 151.0f);
}
__device__ __forceinline__ void attn_wave_unit(const bf16_t* P, bf16_t* YA, int bh, int qb, LAS unsigned char* vl, int lane) {
    const int b = bh >> 3, h = bh & 7, t0 = qb * 32, r = lane & 31, hh = lane >> 5;
    const size_t rowbase = (size_t)b * SEQ, hbase = (size_t)bh * SEQ;
    const bf16_t* Qp = P + PO_Q + (hbase + t0) * 64 + (hh * 32 + r) * 8;
    const bf16_t* Kp = P + PO_K + hbase * 64 + (hh * 32 + r) * 8;
    const bf16_t* Vp = P + PO_V + (hbase + (lane >> 3)) * 64 + (lane & 7) * 8;
    bf16x8 qf[4];
#pragma unroll
    for (int kk = 0; kk < 4; ++kk) qf[kk] = *(const bf16x8*)(Qp + 512 * kk);
    bf16x8 kfA[4], kfB[4]; u32x4 vrA[4], vrB[4];
    const int t1 = t0 >= 32 ? t0 - 32 : 0;
#pragma unroll
    for (int kk = 0; kk < 4; ++kk) kfA[kk] = *(const bf16x8*)(Kp + (size_t)t0 * 64 + 512 * kk);
#pragma unroll
    for (int c = 0; c < 4; ++c) vrA[c] = *(const u32x4*)(Vp + (size_t)(t0 + 8 * c) * 64);
#pragma unroll
    for (int kk = 0; kk < 4; ++kk) kfB[kk] = *(const bf16x8*)(Kp + (size_t)t1 * 64 + 512 * kk);
#pragma unroll
    for (int c = 0; c < 4; ++c) vrB[c] = *(const u32x4*)(Vp + (size_t)(t1 + 8 * c) * 64);
    bf16x8 ut[2];
#pragma unroll
    for (int s = 0; s < 2; ++s)
#pragma unroll
        for (int j = 0; j < 8; ++j) { const int k = 16 * s + 8 * (j >> 2) + 4 * hh + (j & 3); ut[s][j] = (k > r) ? (short)0x3F80 : (short)0; }
    f32x16 negc, ot[2];
#pragma unroll
    for (int i = 0; i < 16; ++i) { negc[i] = 0.f; ot[0][i] = 0.f; ot[1][i] = 0.f; }
    const int q4 = (lane & 15) >> 2, p4 = lane & 3;
    const LAS unsigned char* trb = vl + (4 * hh + q4) * VROW + 32 * ((lane >> 4) & 1) + 8 * p4;
    LAS unsigned char* vw = vl + (lane >> 3) * VROW + (lane & 7) * 16;
    int sb = t0;
    bool done = attn_iter<true>(kfA, vrA, qf, ut, negc, ot, Kp, Vp, sb, vw, trb, r, hh);
    while (!done) {
        sb -= 32; done = attn_iter<false>(kfB, vrB, qf, ut, negc, ot, Kp, Vp, sb, vw, trb, r, hh);
        if (done) break;
        sb -= 32; done = attn_iter<false>(kfA, vrA, qf, ut, negc, ot, Kp, Vp, sb, vw, trb, r, hh);
    }
#pragma unroll
    for (int kk = 0; kk < 4; ++kk) asm volatile("" :: "v"(kfA[kk]), "v"(kfB[kk]), "v"(vrA[kk]), "v"(vrB[kk]));
#pragma unroll
    for (int d = 0; d < 2; ++d)
#pragma unroll
        for (int g4 = 0; g4 < 4; ++g4)
            *(LAS unsigned*)(vl + r * VROW + 32 * d + 8 * g4 + 4 * hh) = pk4_i8(QS_YA * ot[d][4 * g4 + 0], QS_YA * ot[d][4 * g4 + 1], QS_YA * ot[d][4 * g4 + 2], QS_YA * ot[d][4 * g4 + 3]);
    unsigned char* op = (unsigned char*)YA + (rowbase + t0 + (lane >> 2)) * DM + h * 64 + (lane & 3) * 16;
#pragma unroll
    for (int c = 0; c < 2; ++c) { const u32x4 o = *(const LAS u32x4*)(vl + (16 * c + (lane >> 2)) * VROW + (lane & 3) * 16); *(u32x4*)(op + (size_t)(16 * c) * DM) = o; }
}

__device__ __forceinline__ void sgu_unit(const bf16_t* P, bf16_t* YB, const bf16_t* Wsp, const float* g_sgu, const float* b_sp, const f32x2* svst, int ch, int g, LAS unsigned char* vt, int lane) {
    const size_t R0 = (size_t)ch * 128;
    LAS f32x2* st = (LAS f32x2*)(vt + 128 * VROW);
    const int chunk = lane & 7;
    u32x4 vv[16];
#pragma unroll
    for (int c16 = 0; c16 < 16; ++c16) vv[c16] = *(const u32x4*)(P + PO_SV + (R0 + c16 * 8 + (lane >> 3)) * 512 + 64 * g + 8 * chunk);
#pragma unroll
    for (int tt = 0; tt < 2; ++tt) { const f32x4* sp = (const f32x4*)(svst + (R0 + lane + 64 * tt) * 8); float s1 = 0.f, s2 = 0.f;
#pragma unroll
        for (int j = 0; j < 4; ++j) { const f32x4 t4 = sp[j]; s1 += t4.x + t4.z; s2 += t4.y + t4.w; }
        const float mean = s1 * (1.0f / 512.0f), var = __builtin_fmaxf(s2 * (1.0f / 512.0f) - mean * mean, 0.f);
        st[lane + 64 * tt] = (f32x2){mean, 1.0f / __builtin_sqrtf(var + EPS)}; }
    {
        const u32x4 ga = *(const u32x4*)(g_sgu + 64 * g + 8 * chunk), gb = *(const u32x4*)(g_sgu + 64 * g + 8 * chunk + 4);
        const float gv[8] = {__uint_as_float(ga.x), __uint_as_float(ga.y), __uint_as_float(ga.z), __uint_as_float(ga.w), __uint_as_float(gb.x), __uint_as_float(gb.y), __uint_as_float(gb.z), __uint_as_float(gb.w)};
#pragma unroll
        for (int c16 = 0; c16 < 16; ++c16) { const int s = c16 * 8 + (lane >> 3);
            u32x4 v = vv[c16];
            asm volatile("" : "+v"(v));
            const f32x2 ms = st[s];
            float f[8] = {bf_lo(v.x), bf_hi(v.x), bf_lo(v.y), bf_hi(v.y), bf_lo(v.z), bf_hi(v.z), bf_lo(v.w), bf_hi(v.w)};
#pragma unroll
            for (int j = 0; j < 8; ++j) f[j] = (f[j] - ms.x) * ms.y * gv[j];
            u32x4 o; o.x = cvtpk(f[0], f[1]); o.y = cvtpk(f[2], f[3]); o.z = cvtpk(f[4], f[5]); o.w = cvtpk(f[6], f[7]);
            *(LAS u32x4*)(vt + s * VROW + chunk * 16) = o; }
    }
    asm volatile("" ::: "memory");
    const int r = lane & 31, hh = lane >> 5, q4 = (lane & 15) >> 2, p4 = lane & 3;
    const LAS unsigned char* trb = vt + (8 * hh + q4) * VROW + 32 * ((lane >> 4) & 1) + 8 * p4;
    const bf16_t* wp = Wsp + (size_t)g * (4 * 8 * 512) + lane * 8;
    LAS unsigned char* stg = vt + 64 * VROW;
#pragma unroll
    for (int tq = 0; tq < 2; ++tq) {
        const int tp = 1 - tq;
        const bf16_t* wq = wp; asm volatile("" : "+v"(wq));
        f32x16 acc[2][2];
#pragma unroll
        for (int tl = 0; tl < 2; ++tl)
#pragma unroll
            for (int cb = 0; cb < 2; ++cb)
#pragma unroll
                for (int i = 0; i < 16; ++i) acc[tl][cb][i] = 0.f;
        u32x2 uu[2][2][4]; float bs[2];
#pragma unroll
        for (int tl = 0; tl < 2; ++tl) { const int tb = 2 * tp + tl; bs[tl] = b_sp[g * 128 + 32 * tb + r];
            const bf16_t* up = P + PO_U + (((R0 >> 5) + tb) * 64 + 8 * g) * 256 + r * 8 + 4 * hh;
#pragma unroll
            for (int cb = 0; cb < 2; ++cb)
#pragma unroll
                for (int g4 = 0; g4 < 4; ++g4) uu[tl][cb][g4] = *(const u32x2*)(up + (4 * cb + g4) * 256); }
#pragma unroll
        for (int ss = 0; ss < 8; ++ss) if (ss < 4 * tp + 4) {
            bf16x8 af[2];
#pragma unroll
            for (int cb = 0; cb < 2; ++cb) af[cb] = cat4(tr_read(trb + 16 * ss * VROW + 64 * cb), tr_read(trb + (16 * ss + 4) * VROW + 64 * cb));
#pragma unroll
            for (int tl = 0; tl < 2; ++tl) { const int tb = 2 * tp + tl; if (tb >= (ss >> 1)) {
                const bf16x8 bfr = *(const bf16x8*)(wq + (tb * 8 + ss) * 512);
#pragma unroll
                for (int cb = 0; cb < 2; ++cb) acc[tl][cb] = MFMA32(af[cb], bfr, acc[tl][cb]);
            } }
        }
#pragma unroll
        for (int tl = 0; tl < 2; ++tl)
#pragma unroll
            for (int cb = 0; cb < 2; ++cb)
#pragma unroll
                for (int g4 = 0; g4 < 4; ++g4) { const u32x2 u2 = uu[tl][cb][g4];
                    const float y0 = bf_lo(u2.x) * (acc[tl][cb][4 * g4 + 0] + bs[tl]), y1 = bf_hi(u2.x) * (acc[tl][cb][4 * g4 + 1] + bs[tl]);
                    const float y2 = bf_lo(u2.y) * (acc[tl][cb][4 * g4 + 2] + bs[tl]), y3 = bf_hi(u2.y) * (acc[tl][cb][4 * g4 + 3] + bs[tl]);
                    *(LAS unsigned*)(stg + (32 * tl + r) * VROW + 32 * cb + 8 * g4 + 4 * hh) = pk4_i8(QS_YB * y0, QS_YB * y1, QS_YB * y2, QS_YB * y3); }
        unsigned char* yp = (unsigned char*)YB + (R0 + 64 * tp + (lane >> 2)) * DM + 64 * g + (lane & 3) * 16;
#pragma unroll
        for (int j = 0; j < 4; ++j) { const u32x4 o = *(const LAS u32x4*)(stg + (16 * j + (lane >> 2)) * VROW + (lane & 3) * 16); *(u32x4*)(yp + (size_t)(16 * j) * DM) = o; }
        asm volatile("" ::: "memory");
    }
}

__device__ __forceinline__ void bfly_argmax16(float& v, int& idx) {
#pragma unroll
    for (int o = 1; o < 16; o <<= 1) { const float ov = __shfl_xor(v, o); const int oi = __shfl_xor(idx, o);
        const bool take = (ov > v) || (ov == v && oi < idx); v = take ? ov : v; idx = take ? oi : idx; }
}
__device__ __forceinline__ float bfly_sum16(float v) {
#pragma unroll
    for (int o = 1; o < 16; o <<= 1) v += __shfl_xor(v, o);
    return v;
}
#define MFMA16(a, b, c) __builtin_amdgcn_mfma_f32_16x16x32_bf16((a), (b), (c), 0, 0, 0)

__global__ void __launch_bounds__(NWAVES * 64, 2) fwd_kernel(Args args) {
    extern __shared__ __attribute__((aligned(16))) unsigned char lds_raw[];
    LAS unsigned char* lds = (LAS unsigned char*)lds_raw;
    const int tid = threadIdx.x, lane = tid & 63, wave = __builtin_amdgcn_readfirstlane(tid >> 6);
    const int G = gridDim.x, bx = blockIdx.x;
    const int vcu = (G % 8 == 0) ? (bx % 8) * (G / 8) + bx / 8 : bx;
    unsigned char* ws = args.ws;
    gu32* ctl = (gu32*)(ws + WS_CTL);
    volatile LAS unsigned* MISC = (volatile LAS unsigned*)(lds + MISC_OFF);
    for (int u = tid; u < 64; u += NWAVES * 64) MISC[u] = 0u;
    __syncthreads();
    XcdBarrier bar = xcd_barrier_post((unsigned*)(ctl + CW_BAR) + args.li * XCD_BAR_WORDS, MISC + 8);
    const int lo = args.ph_lo, hi = args.ph_hi;
#define IN(k) (lo <= (k) && (k) < hi)
#define SEAM(k) do { if (IN(k) && IN((k) + 1)) xcd_barrier(bar); } while (0)

    const float* X = args.in[I_X];
    float* mod = (float*)(ws + WS_MOD);
    bf16_t* XN = (bf16_t*)(ws + WS_XN);
    bf16_t* Pb = (bf16_t*)(ws + WS_P);
    bf16_t* YAB = (bf16_t*)(ws + WS_YA);
    bf16_t* Hh = YAB;
    float* stats = (float*)(ws + WS_STATS);
    u32x2* list = (u32x2*)(ws + WS_LIST);
    const int gw = vcu * NWAVES + wave, NGW = G * NWAVES;

    if (IN(0)) {
        {
            LAS float* cact = (LAS float*)lds;
            LAS float* part = (LAS float*)(lds + 32768);
            bool filled = false;
            for (int cg = bx; cg < 192; cg += G) {
                if (!filled) { for (int i = tid; i < 8192; i += NWAVES * 64) { const float v = args.in[I_C][i]; cact[i] = v * fast_rcp(1.0f + __expf(-v)); } filled = true; }
                __syncthreads();
                float a[8];
#pragma unroll
                for (int b = 0; b < 8; ++b) a[b] = 0.f;
                const int kbase = 128 * wave + 64 * (lane >> 5);
                const float* wp = args.in[I_WADA] + (size_t)kbase * 6144 + 32 * cg + (lane & 31);
#pragma unroll 16
                for (int k = 0; k < 64; ++k) { const float wv = wp[(size_t)k * 6144];
#pragma unroll
                    for (int b = 0; b < 8; ++b) a[b] += cact[b * 1024 + kbase + k] * wv; }
#pragma unroll
                for (int b = 0; b < 8; ++b) part[(wave * 8 + b) * 64 + lane] = a[b];
                __syncthreads();
                if (tid < 256) { const int b = tid >> 5, j = tid & 31; float s = args.in[I_BADA][32 * cg + j];
#pragma unroll
                    for (int w = 0; w < 8; ++w) s += part[(w * 8 + b) * 64 + j] + part[(w * 8 + b) * 64 + 32 + j];
                    mod[b * 6144 + 32 * cg + j] = s; }
                __syncthreads();
            }
        }
        {
            LAS float* scr = (LAS float*)(lds + 49152 + wave * 8448);
            constexpr int I_IN = 16 * 144, I_A = 8 * 32, I_B = 8 * 32, I_O = 16 * 32, I_E = 768;
            constexpr int NITEMS = I_IN + I_A + I_B + I_O + NEXP * I_E;
            for (int it = gw; it < NITEMS; it += NGW) {
                int r = it;
                if (r < I_IN) { const int kb = r / 144, nb = r % 144; int drow = 32 * nb;
                    if (drow >= C_GA) { const int isb = drow >= C_GB, a = drow - (isb ? C_GB : C_GA); drow = C_GA + 256 * (a >> 7) + 128 * isb + (a & 127); }
                    transpose_tile_i8(args.in[I_WIN] + (size_t)(64 * kb) * LDP + 32 * nb, LDP, (unsigned char*)(ws + WS_WIN) + (size_t)drow * 1024 + 64 * kb, 1024, scr, lane, QS_WIN);
                    continue; } r -= I_IN;
                if (r < I_A) { const int kb = r / 32, nb = r % 32; transpose_tile_i8(args.in[I_WSBA] + (size_t)(64 * kb) * 1024 + 32 * nb, 1024, (unsigned char*)(ws + WS_WA) + (size_t)(32 * nb) * 1024 + 64 * kb, 1024, scr, lane, QS_WAB); continue; } r -= I_A;
                if (r < I_B) { const int kb = r / 32, nb = r % 32; transpose_tile_i8(args.in[I_WSGU] + (size_t)(64 * kb) * 1024 + 32 * nb, 1024, (unsigned char*)(ws + WS_WA) + (size_t)(32 * nb) * 1024 + 512 + 64 * kb, 1024, scr, lane, QS_WAB); continue; } r -= I_B;
                if (r < I_O) { const int kb = r / 32, nb = r % 32; transpose_tile_i8(args.in[I_WOUT] + (size_t)(64 * kb) * 1024 + 32 * nb, 1024, (unsigned char*)(ws + WS_WO) + (size_t)(32 * nb) * 1024 + 64 * kb, 1024, scr, lane, QS_WOUT); continue; } r -= I_O;
                const int e = r / I_E, q = r % I_E;
                if (q < 512) {
                    const int up = q >> 8, qq = q & 255, kb = qq / 16, nb = qq % 16, n0 = 32 * nb;
                    const float* src = args.in[up ? I_WEU : I_WEG] + (size_t)e * 1024 * 512 + (size_t)(64 * kb) * 512 + n0;
                    const int orow = 256 * (n0 >> 7) + 128 * up + (n0 & 127);
                    transpose_tile8(src, 512, (unsigned char*)(ws + WS_BT1) + ((size_t)e * 1024 + orow) * 1024 + 64 * kb, 1024, scr, lane, 32.0f);
                } else {
                    const int qq = q - 512, kb = qq / 32, nb = qq % 32;
                    const float* src = args.in[I_WED] + (size_t)e * 512 * 1024 + (size_t)(64 * kb) * 1024 + 32 * nb;
                    transpose_tile8(src, 1024, (unsigned char*)(ws + WS_BT2) + ((size_t)e * 1024 + 32 * nb) * 512 + 64 * kb, 512, scr, lane, 32.0f);
                }
            }
        }
        { bf16_t* wsp = (bf16_t*)(ws + WS_WSP);
            for (int i = bx * NWAVES * 64 + tid; i < 8 * 128 * 128 / 2; i += G * NWAVES * 64) { const int e0 = 2 * i, j = e0 & 7, ln = (e0 >> 3) & 63, ss = (e0 >> 9) & 7, tb = (e0 >> 12) & 3, g = e0 >> 14;
                const int t = 32 * tb + (ln & 31), s = 16 * ss + 8 * (ln >> 5) + j;
                const f32x2 w = *(const f32x2*)(args.in[I_WSP] + ((size_t)g * 128 + t) * 128 + s); ((unsigned*)wsp)[i] = cvtpk(s <= t ? w.x : 0.f, (s + 1) <= t ? w.y : 0.f); } }
        { bf16_t* wr = (bf16_t*)(ws + WS_WR);
            for (int i = bx * NWAVES * 64 + tid; i < 36 * 1024; i += G * NWAVES * 64) { const int c = i >> 10, k = i & 1023;
                const float w = (c < 32) ? args.in[I_WRE][k * 32 + c] : args.in[I_WRG][k * 4 + (c - 32)];
                const unsigned hb = cvtpk(w, 0.f) & 0xffffu; const float hf = __uint_as_float(hb << 16);
                wr[i] = (bf16_t)hb; wr[36 * 1024 + i] = (bf16_t)(cvtpk(w - hf, 0.f) & 0xffffu); } }
    }
    SEAM(0);

    if (IN(1)) {
        const float* gm = args.in[I_GMIX];
        for (int m = 2 * gw; m < NTOK; m += 2 * NGW) {
            const int b = m / SEQ; const float* sh = mod + b * 6144; const float* sc = sh + DM;
            const f32x4* xr = (const f32x4*)(X + (size_t)m * DM) + lane;
            f32x4 v[2][4]; float s0 = 0.f, s1 = 0.f;
#pragma unroll
            for (int j = 0; j < 4; ++j) { v[0][j] = xr[64 * j]; v[1][j] = xr[256 + 64 * j]; }
#pragma unroll
            for (int j = 0; j < 4; ++j) { s0 += (v[0][j].x * v[0][j].x + v[0][j].y * v[0][j].y) + (v[0][j].z * v[0][j].z + v[0][j].w * v[0][j].w);
                s1 += (v[1][j].x * v[1][j].x + v[1][j].y * v[1][j].y) + (v[1][j].z * v[1][j].z + v[1][j].w * v[1][j].w); }
            const float r0 = 1.0f / __builtin_sqrtf(wave_sum(s0) * (1.0f / DM) + EPS), r1 = 1.0f / __builtin_sqrtf(wave_sum(s1) * (1.0f / DM) + EPS);
            unsigned* n8 = (unsigned*)((unsigned char*)XN + (size_t)m * DM) + lane;
#pragma unroll
            for (int j = 0; j < 4; ++j) { const int c = 4 * lane + 256 * j; const f32x4 g4 = *(const f32x4*)(gm + c), s4 = *(const f32x4*)(sc + c), h4 = *(const f32x4*)(sh + c);
                const f32x4 gs = g4 * (s4 + 1.0f);
                const f32x4 n0 = (v[0][j] * r0) * gs + h4, n1 = (v[1][j] * r1) * gs + h4;
                n8[64 * j] = pk4_i8(QS_N * n0.x, QS_N * n0.y, QS_N * n0.z, QS_N * n0.w); n8[256 + 64 * j] = pk4_i8(QS_N * n1.x, QS_N * n1.y, QS_N * n1.z, QS_N * n1.w); }
        }
    }
    SEAM(1);

    if (IN(2)) {
        pg8::Gemm g{XN, (const bf16_t*)(ws + WS_WIN), DM, DM, DM}; pg8::StaticOrder S; S.init(NTOK, LDP, G, bx);
        pg8::EpiProj E{Pb, (f32x2*)(ws + WS_STATS)};
        pg8::gemm_phase<pg8::EpiProj, pg8::StaticOrder, true, false, false, false, true>(lds, g, S, E, nullptr);
    }
    SEAM(2);

    if (IN(3)) {
        LAS unsigned char* wl = lds + wave * (128 * VROW + 1024);
        volatile LAS unsigned* qctr = MISC + 16;
        if (tid == 0) { qctr[0] = 0u; qctr[1] = 0u; }
        __syncthreads();
        const int n_att = (NB * 8 * (SEQ / 32) + G - 1) / G;
        for (;;) {
            int k = 0;
            if (lane == 0) k = (int)__hip_atomic_fetch_add((LAS unsigned*)qctr, 1u, __ATOMIC_RELAXED, __HIP_MEMORY_SCOPE_WORKGROUP);
            k = __builtin_amdgcn_readfirstlane(k);
            if (k >= n_att) break;
            const int bhh = 8 * (vcu & 7) + (k >> 3), qbb = 8 * (vcu >> 3) + (k & 7);
            attn_wave_unit(Pb, YAB, bhh, qbb, wl, lane);
        }
        const int n_sgu = ((NTOK / 128 + G - 1) / G) * 8;
        for (;;) {
            int k = 0;
            if (lane == 0) k = (int)__hip_atomic_fetch_add((LAS unsigned*)(qctr + 1), 1u, __ATOMIC_RELAXED, __HIP_MEMORY_SCOPE_WORKGROUP);
            k = __builtin_amdgcn_readfirstlane(k);
            const int ch = vcu + (k >> 3) * G;
            if (k >= n_sgu || ch >= NTOK / 128) break;
            sgu_unit(Pb, (bf16_t*)((unsigned char*)YAB + 512), (const bf16_t*)(ws + WS_WSP), args.in[I_GSGU], args.in[I_BSP], (const f32x2*)(ws + WS_STATS), ch, k & 7, wl, lane);
        }
        __syncthreads();
    }
    SEAM(3);

    if (IN(4)) {
        pg8::Gemm g{YAB, (const bf16_t*)(ws + WS_WA), DM, DM, DM}; pg8::StaticOrder S; S.init(NTOK, DM, G, bx);
        pg8::EpiMerge E{(unsigned char*)XN, Pb};
        pg8::gemm_phase<pg8::EpiMerge, pg8::StaticOrder, true, false, true, false, true>(lds, g, S, E, nullptr);
    }
    SEAM(4);

    if (IN(5)) {
        pg8::Gemm g{XN, (const bf16_t*)(ws + WS_WO), DM, DM, DM}; pg8::StaticOrder S; S.init(NTOK, DM, G, bx);
        { LAS unsigned* gt5 = (LAS unsigned*)(lds + GTAB_OFF);
            pg8::Unit uu; for (int i = 0; i < 9 && S.next(i, uu); ++i) if (tid < 256) gt5[i * 256 + tid] = (unsigned)(uu.pm * 256 + tid) * (unsigned)DM;
            __syncthreads(); }
        pg8::EpiResid E{X, Hh, mod, stats};
        pg8::gemm_phase<pg8::EpiResid, pg8::StaticOrder, true, true, false, false, true>(lds, g, S, E, (const LAS unsigned*)(lds + GTAB_OFF));
    }
    SEAM(5);

    if (IN(6)) {
        { const u32x4* src = (const u32x4*)(ws + WS_WR);
            for (int i = tid; i < 2 * 36 * 128; i += NWAVES * 64) { const int row = i >> 7, chn = i & 127;
                *(LAS u32x4*)(lds + row * 2048 + ((chn ^ (row % 36 & 15)) << 4)) = src[i]; } }
        const int tpb = (NTOK / 16 + G - 1) / G;
        LAS float* A1 = (LAS float*)(lds + 147456); LAS float* A0 = A1 + DM;
        LAS u32x2* rbuf = (LAS u32x2*)(lds + 155648);
        LAS unsigned* lcnt = (LAS unsigned*)(lds + 159744); LAS unsigned* lbase = lcnt + NEXP;
        if (tid < NEXP) lcnt[tid] = 0u;
        { const int b0 = (vcu * tpb * 16) / SEQ; const float* sh = mod + b0 * 6144 + 3 * DM; const float* sc = sh + DM;
            for (int k = tid; k < DM; k += NWAVES * 64) { A1[k] = args.in[I_GFFN][k] * (1.0f + sc[k]); A0[k] = sh[k]; } }
        __syncthreads();
        const int rr = lane & 15, q = lane >> 4;
        for (int ti = wave; ti < tpb; ti += NWAVES) {
            const int task = vcu * tpb + ti; if (task >= NTOK / 16) break;
            const int R0 = task * 16, row = R0 + rr;
            float ssq = 0.f;
            { const f32x4* sp = (const f32x4*)(stats + (size_t)row * 16);
#pragma unroll
                for (int j = 0; j < 4; ++j) { const f32x4 t4 = sp[j]; ssq += (t4.x + t4.y) + (t4.z + t4.w); } }
            const float rstd = 1.0f / __builtin_sqrtf(ssq * (1.0f / DM) + EPS);
            f32x4 a0 = {0.f, 0.f, 0.f, 0.f}, a1 = a0, a2 = a0;
            const bf16_t* hp = Hh + (size_t)row * DM + 8 * q;
            unsigned char* np = (unsigned char*)XN + (size_t)row * DM + 8 * q;
            const int sw = rr;
            for (int kb = 0; kb < 4; ++kb) {
                u32x4 hq[8];
#pragma unroll
                for (int j = 0; j < 8; ++j) hq[j] = *(const u32x4*)(hp + 32 * (8 * kb + j));
#pragma unroll
                for (int j = 0; j < 8; ++j) {
                const int kk = 8 * kb + j, k0 = 32 * kk + 8 * q;
                const u32x4 hv = hq[j];
                const f32x4 h0 = {bf_lo(hv.x), bf_hi(hv.x), bf_lo(hv.y), bf_hi(hv.y)}, h1 = {bf_lo(hv.z), bf_hi(hv.z), bf_lo(hv.w), bf_hi(hv.w)};
                const f32x4 m0 = *(const LAS f32x4*)(A1 + k0), m1 = *(const LAS f32x4*)(A1 + k0 + 4);
                const f32x4 s0 = *(const LAS f32x4*)(A0 + k0), s1 = *(const LAS f32x4*)(A0 + k0 + 4);
                const f32x4 n0 = (h0 * rstd) * m0 + s0, n1 = (h1 * rstd) * m1 + s1;
                u32x4 hi4; hi4.x = cvtpk(n0.x, n0.y); hi4.y = cvtpk(n0.z, n0.w); hi4.z = cvtpk(n1.x, n1.y); hi4.w = cvtpk(n1.z, n1.w);
                { u32x2 n8; n8.x = pk4_fp8(n0.x, n0.y, n0.z, n0.w); n8.y = pk4_fp8(n1.x, n1.y, n1.z, n1.w); *(u32x2*)(np + 32 * kk) = n8; }
                u32x4 lo4; lo4.x = cvtpk(n0.x - bf_lo(hi4.x), n0.y - bf_hi(hi4.x)); lo4.y = cvtpk(n0.z - bf_lo(hi4.y), n0.w - bf_hi(hi4.y));
                lo4.z = cvtpk(n1.x - bf_lo(hi4.z), n1.y - bf_hi(hi4.z)); lo4.w = cvtpk(n1.z - bf_lo(hi4.w), n1.w - bf_hi(hi4.w));
                const bf16x8 Ah = __builtin_bit_cast(bf16x8, hi4), Al = __builtin_bit_cast(bf16x8, lo4);
                const int chn = ((4 * kk + q) ^ sw) << 4;
                const bf16x8 b0h = *(const LAS bf16x8*)(lds + (rr) * 2048 + chn), b0l = *(const LAS bf16x8*)(lds + (36 + rr) * 2048 + chn);
                const bf16x8 b1h = *(const LAS bf16x8*)(lds + (16 + rr) * 2048 + chn), b1l = *(const LAS bf16x8*)(lds + (52 + rr) * 2048 + chn);
                bf16x8 b2h = *(const LAS bf16x8*)(lds + (32 + (rr & 3)) * 2048 + (((4 * kk + q) ^ (rr & 3)) << 4)), b2l = *(const LAS bf16x8*)(lds + (68 + (rr & 3)) * 2048 + (((4 * kk + q) ^ (rr & 3)) << 4));
                if (rr >= 4) { b2h = (bf16x8){0, 0, 0, 0, 0, 0, 0, 0}; b2l = b2h; }
                a0 = MFMA16(Ah, b0h, a0); a0 = MFMA16(Al, b0h, a0); a0 = MFMA16(Ah, b0l, a0);
                a1 = MFMA16(Ah, b1h, a1); a1 = MFMA16(Al, b1h, a1); a1 = MFMA16(Ah, b1l, a1);
                a2 = MFMA16(Ah, b2h, a2); a2 = MFMA16(Al, b2h, a2); a2 = MFMA16(Ah, b2l, a2);
                }
            }
            const float brg = (rr < 4) ? args.in[I_BRG][rr] : 0.f;
            const float bre0 = args.in[I_BRE][rr], bre1 = args.in[I_BRE][16 + rr];
#pragma unroll
            for (int reg = 0; reg < 4; ++reg) {
                float gl = (rr < 4) ? (a2[reg] + brg) : -INFINITY; const float gl_own = gl; int gi = rr;
                bfly_argmax16(gl, gi);
                const float ge = (rr < 4) ? __expf(gl_own - gl) : 0.f;
                const float gwt = 1.0f / bfly_sum16(ge);
                const int ct = gi >> 1, half = gi & 1;
                const float ev_own = (ct ? (a1[reg] + bre1) : (a0[reg] + bre0));
                const bool valid = ((rr >> 3) == half);
                float m1 = valid ? ev_own : -INFINITY; int i1 = rr & 7;
                bfly_argmax16(m1, i1);
                float m2 = (valid && (rr & 7) != i1) ? ev_own : -INFINITY; int i2 = rr & 7;
                bfly_argmax16(m2, i2);
                const float e2 = __expf(m2 - m1), p1 = 1.0f / (1.0f + e2), p2 = e2 * p1;
                if (rr == 0) {
                    const int rl = ti * 16 + 4 * q + reg;
                    const int e1 = gi * 8 + i1, e2i = gi * 8 + i2;
                    const unsigned s1 = __hip_atomic_fetch_add(lcnt + e1, 1u, __ATOMIC_RELAXED, __HIP_MEMORY_SCOPE_WORKGROUP);
                    const unsigned s2 = __hip_atomic_fetch_add(lcnt + e2i, 1u, __ATOMIC_RELAXED, __HIP_MEMORY_SCOPE_WORKGROUP);
                    rbuf[2 * rl] = (u32x2){((unsigned)e1 << 16) | s1, __float_as_uint(p1 * gwt)};
                    rbuf[2 * rl + 1] = (u32x2){((unsigned)e2i << 16) | s2, __float_as_uint(p2 * gwt)};
                }
            }
        }
        __syncthreads();
        if (tid < NEXP) lbase[tid] = __hip_atomic_fetch_add((unsigned*)(ctl + CW_CNT + 64 * tid), lcnt[tid], __ATOMIC_RELAXED, __HIP_MEMORY_SCOPE_AGENT);
        __syncthreads();
        for (int t = tid; t < tpb * 32; t += NWAVES * 64) { const int rl = t >> 1; const int task = vcu * tpb + (rl >> 4);
            if (task < NTOK / 16) { const u32x2 en = rbuf[t]; const unsigned e = en.x >> 16, slot = en.x & 0xffffu;
                list[(size_t)e * NTOK + lbase[e] + slot] = (u32x2){(unsigned)(task * 16 + (rl & 15)) * 2u + (unsigned)(t & 1), en.y}; } }
        __syncthreads();
    }
    SEAM(6);

    LAS int* utab = (LAS int*)(lds + UTAB_OFF);
    LAS int* moeb = (LAS int*)(lds + MOEB_OFF);
    LAS unsigned* gtab = (LAS unsigned*)(lds + GTAB_OFF);
    int n_units = 0;
    if (IN(7) || IN(8)) {
        if (tid < NEXP) moeb[33 + tid] = (int)__hip_atomic_load((unsigned*)(ctl + CW_CNT + 64 * tid), __ATOMIC_RELAXED, __HIP_MEMORY_SCOPE_AGENT);
        __syncthreads();
        if (tid == 0) { int acc = 0;
            for (int e = 0; e < NEXP; ++e) { moeb[e] = acc; acc += (moeb[33 + e] + 255) >> 8; }
            moeb[32] = acc; }
        __syncthreads();
        const int total4 = moeb[32] * 4;
        if (tid < 9) { const int L = tid * G + vcu; int pm = 0, pn = 0;
            if (L < total4) { const int rb = L >> 2; int e = 0; for (int k = 1; k < NEXP; ++k) e += (rb >= moeb[k]) ? 1 : 0; pm = rb; pn = e * 4 + (L & 3); }
            utab[2 * tid] = pm; utab[2 * tid + 1] = pn; }
        for (int i = 0; i < 9; ++i) if (i * G + vcu < total4) n_units = i + 1;
        __syncthreads();
    }

    if (IN(7)) {
        for (int t = tid; t < n_units * 256; t += NWAVES * 64) { const int i = t >> 8, rw = t & 255; const int pm = utab[2 * i], e = utab[2 * i + 1] >> 2; const int idx = (pm - moeb[e]) * 256 + rw;
            unsigned tok = 0u; if (idx < moeb[33 + e]) tok = list[(size_t)e * NTOK + idx].x >> 1; gtab[t] = tok * (unsigned)DM; }
        __syncthreads();
        pg8::Gemm g{XN, (const bf16_t*)(ws + WS_BT1), DM, DM, DM}; pg8::TableOrder S{utab, n_units};
        pg8::EpiSwiglu E{(unsigned char*)(ws + WS_HID)};
        pg8::gemm_phase<pg8::EpiSwiglu, pg8::TableOrder, true, true, false, true>(lds, g, S, E, gtab);
    }
    SEAM(7);

    if (IN(8)) {
        LAS u32x2* etab = (LAS u32x2*)(lds + ETAB_OFF);
        for (int t = tid; t < n_units * 256; t += NWAVES * 64) { const int i = t >> 8, rw = t & 255; const int pm = utab[2 * i], e = utab[2 * i + 1] >> 2; const int idx = (pm - moeb[e]) * 256 + rw;
            u32x2 en = {0xffffffffu, 0u}; if (idx < moeb[33 + e]) en = list[(size_t)e * NTOK + idx]; etab[t] = en;
            gtab[t] = (unsigned)(pm * 256 + rw) * (unsigned)DEXP; }
        __syncthreads();
        pg8::Gemm g{(const bf16_t*)(ws + WS_HID), (const bf16_t*)(ws + WS_BT2), DEXP, DEXP, DEXP}; pg8::TableOrder S{utab, n_units};
        pg8::EpiScatter E{(unsigned char*)(ws + WS_YBUF), etab};
        pg8::gemm_phase<pg8::EpiScatter, pg8::TableOrder, true, true, false, true>(lds, g, S, E, gtab);
    }
    SEAM(8);

    if (IN(9)) {
        const float* gfin = args.in[I_GFIN];
        const unsigned char* Yb = (const unsigned char*)(ws + WS_YBUF);
        const unsigned tmo = __hip_atomic_load((unsigned*)(ctl + CW_BAR) + XB_TMO, __ATOMIC_RELAXED, __HIP_MEMORY_SCOPE_AGENT);
        for (int m = 2 * gw; m < NTOK; m += 2 * NGW) {
            const int b = m / SEQ; const float* gt = mod + b * 6144 + 5 * DM;
            u32x4 hv[2][2]; u32x2 ya[2][2], yb[2][2];
#pragma unroll
            for (int rr = 0; rr < 2; ++rr)
#pragma unroll
                for (int j = 0; j < 2; ++j) { const int c = 8 * lane + 512 * j;
                    hv[rr][j] = *(const u32x4*)(Hh + (size_t)(m + rr) * DM + c);
                    ya[rr][j] = *(const u32x2*)(Yb + (size_t)(2 * (m + rr)) * DM + c); yb[rr][j] = *(const u32x2*)(Yb + (size_t)(2 * (m + rr) + 1) * DM + c); }
            float v[2][16]; float ss[2] = {0.f, 0.f};
#pragma unroll
            for (int j = 0; j < 2; ++j) { const int c = 8 * lane + 512 * j;
                const f32x4 g0 = *(const f32x4*)(gt + c) * 0.0625f, g1 = *(const f32x4*)(gt + c + 4) * 0.0625f;
#pragma unroll
                for (int rr = 0; rr < 2; ++rr) { const u32x4 h = hv[rr][j]; const u32x2 a = ya[rr][j], bq = yb[rr][j];
                    const f32x2 a01 = __builtin_amdgcn_cvt_pk_f32_fp8((int)a.x, false), a23 = __builtin_amdgcn_cvt_pk_f32_fp8((int)a.x, true), a45 = __builtin_amdgcn_cvt_pk_f32_fp8((int)a.y, false), a67 = __builtin_amdgcn_cvt_pk_f32_fp8((int)a.y, true);
                    const f32x2 b01 = __builtin_amdgcn_cvt_pk_f32_fp8((int)bq.x, false), b23 = __builtin_amdgcn_cvt_pk_f32_fp8((int)bq.x, true), b45 = __builtin_amdgcn_cvt_pk_f32_fp8((int)bq.y, false), b67 = __builtin_amdgcn_cvt_pk_f32_fp8((int)bq.y, true);
                    v[rr][8 * j + 0] = bf_lo(h.x) + g0.x * (a01[0] + b01[0]); v[rr][8 * j + 1] = bf_hi(h.x) + g0.y * (a01[1] + b01[1]);
                    v[rr][8 * j + 2] = bf_lo(h.y) + g0.z * (a23[0] + b23[0]); v[rr][8 * j + 3] = bf_hi(h.y) + g0.w * (a23[1] + b23[1]);
                    v[rr][8 * j + 4] = bf_lo(h.z) + g1.x * (a45[0] + b45[0]); v[rr][8 * j + 5] = bf_hi(h.z) + g1.y * (a45[1] + b45[1]);
                    v[rr][8 * j + 6] = bf_lo(h.w) + g1.z * (a67[0] + b67[0]); v[rr][8 * j + 7] = bf_hi(h.w) + g1.w * (a67[1] + b67[1]);
#pragma unroll
                    for (int i = 0; i < 8; ++i) ss[rr] += v[rr][8 * j + i] * v[rr][8 * j + i]; } }
            float rs[2];
#pragma unroll
            for (int rr = 0; rr < 2; ++rr) { rs[rr] = 1.0f / __builtin_sqrtf(wave_sum(ss[rr]) * (1.0f / DM) + EPS); if (tmo) rs[rr] = __builtin_nanf(""); }
#pragma unroll
            for (int j = 0; j < 2; ++j) { const int c = 8 * lane + 512 * j;
                const f32x4 g0 = *(const f32x4*)(gfin + c), g1 = *(const f32x4*)(gfin + c + 4);
#pragma unroll
                for (int rr = 0; rr < 2; ++rr) { float* orow = args.out + (size_t)(m + rr) * DM + c;
                    f32x4 o0, o1; o0.x = v[rr][8 * j + 0] * rs[rr] * g0.x; o0.y = v[rr][8 * j + 1] * rs[rr] * g0.y; o0.z = v[rr][8 * j + 2] * rs[rr] * g0.z; o0.w = v[rr][8 * j + 3] * rs[rr] * g0.w;
                    o1.x = v[rr][8 * j + 4] * rs[rr] * g1.x; o1.y = v[rr][8 * j + 5] * rs[rr] * g1.y; o1.z = v[rr][8 * j + 6] * rs[rr] * g1.z; o1.w = v[rr][8 * j + 7] * rs[rr] * g1.w;
                    *(f32x4*)orow = o0; *(f32x4*)(orow + 4) = o1; } }
        }
    }
#undef IN
#undef SEAM
}

extern "C" void kernel_launch(void* const* d_in, const int* in_sizes, int n_in, void* d_out, int out_size, void* d_ws, size_t ws_size, hipStream_t stream) {
    static int grid = 0;
    if (grid == 0) {
        if (n_in != 21 || in_sizes[0] != NTOK * DM || out_size != NTOK * DM || ws_size < WS_END) { fprintf(stderr, "kernel_launch: unexpected shapes (n_in %d, in0 %d, out %d, ws %zu)\n", n_in, n_in > 0 ? in_sizes[0] : -1, out_size, ws_size); grid = -1; return; }
        int dev = 0, cus = 0;
        if (hipGetDevice(&dev) != hipSuccess || hipDeviceGetAttribute(&cus, hipDeviceAttributeMultiprocessorCount, dev) != hipSuccess) { grid = -1; return; }
        if (hipFuncSetAttribute((const void*)fwd_kernel, hipFuncAttributeMaxDynamicSharedMemorySize, LDS_BYTES) != hipSuccess) { fprintf(stderr, "kernel_launch: hipFuncSetAttribute failed\n"); grid = -1; return; }
        int per_cu = 0;
        if (hipOccupancyMaxActiveBlocksPerMultiprocessor(&per_cu, (const void*)fwd_kernel, NWAVES * 64, LDS_BYTES) != hipSuccess || per_cu < 1) fprintf(stderr, "kernel_launch: occupancy query says %d\n", per_cu);
        (void)hipGetLastError();
        if (cus != 256) { fprintf(stderr, "kernel_launch: built for 256 CUs, found %d\n", cus); grid = -1; return; }
        grid = cus;
    }
    if (grid < 0) return;
    if (hipMemsetAsync((char*)d_ws + WS_CTL, 0, CTL_ZERO_BYTES, stream) != hipSuccess) return;
    Args a{};
    for (int i = 0; i < 21; ++i) a.in[i] = (const float*)d_in[i];
    a.out = (float*)d_out; a.ws = (unsigned char*)d_ws; a.pad = 0;
    constexpr int NPH = 10;
#if MK_N_LAUNCHES == 1
    a.ph_lo = 0; a.ph_hi = NPH; a.li = 0;
    hipLaunchKernelGGL(fwd_kernel, dim3(grid), dim3(NWAVES * 64), LDS_BYTES, stream, a);
#else
    for (int li = 0; li < NPH; ++li) { a.ph_lo = li; a.ph_hi = li + 1; a.li = 0;
        hipLaunchKernelGGL(fwd_kernel, dim3(grid), dim3(NWAVES * 64), LDS_BYTES, stream, a); }
#endif
}
```
